# Optimizing an MI355X kernel written in HIP

```python
import math
import jax, jax.numpy as jnp
from jax import lax
import numpy as np

D_MODEL = 1024
BATCH = 2
SEQ = 8192
DEPTH = 1
DEC_BATCH = 2
DEC_SEQ = 16384
PAST_LEN = 128

N_META = 16
MLA_H = 8
NOPE_DIM = 128
ROPE_DIM = 64
QK_DIM = NOPE_DIM + ROPE_DIM
V_DIM = 128
Q_LORA = 768
KV_LORA = 256
ROPE_THETA = 10000.0
Q_BLOCK = 128
GLA_H = 4
GLA_DK = 128
GLA_DV = 256
GATE_RANK = 16
GATE_TEMP = 16.0
GLA_CHUNK = 64
META_PAD = GLA_CHUNK - N_META
D_FF = 2816
NORM_EPS = 1e-6

IN_SIZES = (Q_LORA, KV_LORA, ROPE_DIM,
            GLA_H * GLA_DK, GLA_H * GLA_DK, GLA_H * GLA_DV, GLA_H * GLA_DV,
            GATE_RANK, GATE_RANK,
            D_MODEL, D_MODEL)
D_IN = Q_LORA + KV_LORA + ROPE_DIM + 2 * GLA_H * GLA_DK + 2 * GLA_H * GLA_DV + 2 * GATE_RANK + 2 * D_MODEL

kernel_name = "hybrid_mla_gla_gated_encoder"


def rmsnorm(x, g):
    xf = x.astype(jnp.float32)
    y = xf * lax.rsqrt(jnp.mean(xf * xf, axis=-1, keepdims=True) + NORM_EPS)
    return (y * g.astype(jnp.float32)).astype(x.dtype)


def split_cols(z, sizes):
    out = []
    off = 0
    for s in sizes:
        out.append(z[..., off:off + s])
        off += s
    return out


def rope_tables(length):
    inv = 1.0 / (ROPE_THETA ** (jnp.arange(0, ROPE_DIM, 2, dtype=jnp.float32) / ROPE_DIM))
    ang = jnp.arange(length, dtype=jnp.float32)[:, None] * inv[None, :]
    return jnp.cos(ang), jnp.sin(ang)


def apply_rope(x, cos, sin):
    xf = x.astype(jnp.float32)
    half = ROPE_DIM // 2
    x1, x2 = xf[..., :half], xf[..., half:]
    c = cos[None, :, None, :]
    s = sin[None, :, None, :]
    return jnp.concatenate([x1 * c - x2 * s, x2 * c + x1 * s], axis=-1).astype(x.dtype)


def block_attention(q, k, v):
    b, length, h, d = q.shape
    n_blk = -(-length // Q_BLOCK)
    pad = n_blk * Q_BLOCK - length
    qp = jnp.pad(q, ((0, 0), (0, pad), (0, 0), (0, 0)))
    qp = qp.reshape(b, n_blk, Q_BLOCK, h, d).transpose(1, 0, 2, 3, 4)
    scale = QK_DIM ** -0.5

    def one_block(qb):
        s = jnp.einsum('bqhd,bkhd->bhqk', qb, k, preferred_element_type=jnp.float32) * scale
        p = jax.nn.softmax(s, axis=-1)
        return jnp.einsum('bhqk,bkhv->bqhv', p.astype(v.dtype), v)

    o = lax.map(one_block, qp)
    o = o.transpose(1, 0, 2, 3, 4).reshape(b, n_blk * Q_BLOCK, h, v.shape[-1])
    return o[:, :length]


def mla_branch(c_q, c_kv, k_rope, q_a_norm, w_uq, kv_a_norm, w_ukv, q_norm, k_norm, w_o, cos, sin):
    b, length, _ = c_q.shape
    q = (rmsnorm(c_q, q_a_norm) @ w_uq).reshape(b, length, MLA_H, QK_DIM)
    kv = (rmsnorm(c_kv, kv_a_norm) @ w_ukv).reshape(b, length, MLA_H, NOPE_DIM + V_DIM)
    k_nope, v = kv[..., :NOPE_DIM], kv[..., NOPE_DIM:]
    k_r = jnp.broadcast_to(k_rope[:, :, None, :], (b, length, MLA_H, ROPE_DIM))
    k = jnp.concatenate([k_nope, k_r], axis=-1)
    q = rmsnorm(q, q_norm)
    k = rmsnorm(k, k_norm)
    q = jnp.concatenate([q[..., :NOPE_DIM], apply_rope(q[..., NOPE_DIM:], cos, sin)], axis=-1)
    k = jnp.concatenate([k[..., :NOPE_DIM], apply_rope(k[..., NOPE_DIM:], cos, sin)], axis=-1)
    o = block_attention(q, k, v)
    return o.reshape(b, length, MLA_H * V_DIM) @ w_o


def gla_chunked(q, k, v, log_g):
    b, t, h, dk = q.shape
    dv = v.shape[-1]
    n = t // GLA_CHUNK
    f32 = jnp.float32
    qc = q.astype(f32).reshape(b, n, GLA_CHUNK, h, dk)
    kc = k.astype(f32).reshape(b, n, GLA_CHUNK, h, dk)
    vc = v.astype(f32).reshape(b, n, GLA_CHUNK, h, dv)
    bcum = jnp.cumsum(log_g.astype(f32).reshape(b, n, GLA_CHUNK, h, dk), axis=2)
    b_last = bcum[:, :, -1:]
    b_ref = bcum[:, :, GLA_CHUNK // 2 - 1:GLA_CHUNK // 2]
    a = jnp.einsum('bnihd,bnjhd->bnhij', qc * jnp.exp(bcum - b_ref), kc * jnp.exp(b_ref - bcum))
    causal = jnp.tril(jnp.ones((GLA_CHUNK, GLA_CHUNK), dtype=bool))
    a = jnp.where(causal, a, 0.0)
    o_intra = jnp.einsum('bnhij,bnjhv->bnihv', a, vc)
    u = jnp.einsum('bnchd,bnchv->nbhdv', kc * jnp.exp(b_last - bcum), vc)
    decay = jnp.exp(b_last[:, :, 0]).transpose(1, 0, 2, 3)

    def step(s, inp):
        d, u_n = inp
        return d[..., None] * s + u_n, s

    _, s_prev = lax.scan(step, jnp.zeros((b, h, dk, dv), f32), (decay, u))
    o_inter = jnp.einsum('bnchd,nbhdv->bnchv', qc * jnp.exp(bcum), s_prev)
    return (o_intra + o_inter).reshape(b, t, h, dv).astype(v.dtype)


def gla_branch(q, k, v, g, a_f, a_b, w_a2_f, b_a2_f, w_a2_b, b_a2_b, o_norm, w_o):
    b, length, _ = q.shape
    q = q.reshape(b, length, GLA_H, GLA_DK) * (GLA_DK ** -0.5)
    k = k.reshape(b, length, GLA_H, GLA_DK)
    v = v.reshape(b, length, GLA_H, GLA_DV)
    lg_f = (jax.nn.log_sigmoid((a_f @ w_a2_f + b_a2_f).astype(jnp.float32)) / GATE_TEMP).reshape(b, length, GLA_H, GLA_DK)
    lg_b = (jax.nn.log_sigmoid((a_b @ w_a2_b + b_a2_b).astype(jnp.float32)) / GATE_TEMP).reshape(b, length, GLA_H, GLA_DK)
    pad = ((0, 0), (META_PAD, 0), (0, 0), (0, 0))
    qp, kp, vp = jnp.pad(q, pad), jnp.pad(k, pad), jnp.pad(v, pad)
    lfp, lbp = jnp.pad(lg_f, pad), jnp.pad(lg_b, pad)
    o_f = gla_chunked(qp, kp, vp, lfp)
    o_b = jnp.flip(gla_chunked(jnp.flip(qp, 1), jnp.flip(kp, 1), jnp.flip(vp, 1), jnp.flip(lbp, 1)), 1)
    o = (o_f + o_b)[:, META_PAD:]
    o = rmsnorm(o, o_norm) * jax.nn.silu(g).reshape(b, length, GLA_H, GLA_DV)
    return o.reshape(b, length, GLA_H * GLA_DV) @ w_o


def encoder_layer(x, attn_norm, w_in, q_a_norm, w_uq, kv_a_norm, w_ukv, q_norm, k_norm, w_o_mla,
                  w_a2_fwd, b_a2_fwd, w_a2_bwd, b_a2_bwd, gla_o_norm, w_o_gla, w_out,
                  ffn_norm, w_ffn_gate, w_ffn_up, w_ffn_down):
    length = x.shape[1]
    h = rmsnorm(x, attn_norm)
    z = h @ w_in
    (c_q, c_kv, k_rope, gq, gk, gv, gg, a_f, a_b, gate_a, gate_b) = split_cols(z, IN_SIZES)
    cos, sin = rope_tables(length)
    y_a = mla_branch(c_q, c_kv, k_rope, q_a_norm, w_uq, kv_a_norm, w_ukv, q_norm, k_norm, w_o_mla, cos, sin)
    y_b = gla_branch(gq, gk, gv, gg, a_f, a_b, w_a2_fwd, b_a2_fwd, w_a2_bwd, b_a2_bwd, gla_o_norm, w_o_gla)
    mixed = (jax.nn.sigmoid(gate_a) * y_a + jax.nn.sigmoid(gate_b) * y_b) @ w_out
    x = x + mixed
    h = rmsnorm(x, ffn_norm)
    x = x + (jax.nn.silu(h @ w_ffn_gate) * (h @ w_ffn_up)) @ w_ffn_down
    return x


def setup_inputs(seed: int = 0) -> dict:
    key = jax.random.key(seed)
    ks = jax.random.split(key, 24)
    f32 = jnp.float32

    def nrm(k, shape, scale):
        return jax.random.normal(k, shape, f32) * scale

    def gain(k, n):
        return 1.0 + 0.01 * jax.random.normal(k, (DEPTH, n), f32)

    return {
        "x_prompt": nrm(ks[0], (BATCH, SEQ, D_MODEL), 1.0),
        "x_sample": nrm(ks[1], (DEC_BATCH, DEC_SEQ, D_MODEL), 1.0),
        "meta_tokens": nrm(ks[2], (N_META, D_MODEL), 1.0),
        "attn_norm": gain(ks[3], D_MODEL),
        "w_in": nrm(ks[4], (DEPTH, D_MODEL, D_IN), D_MODEL ** -0.5),
        "q_a_norm": gain(ks[5], Q_LORA),
        "w_uq": nrm(ks[6], (DEPTH, Q_LORA, MLA_H * QK_DIM), Q_LORA ** -0.5),
        "kv_a_norm": gain(ks[7], KV_LORA),
        "w_ukv": nrm(ks[8], (DEPTH, KV_LORA, MLA_H * (NOPE_DIM + V_DIM)), KV_LORA ** -0.5),
        "q_norm": gain(ks[9], QK_DIM),
        "k_norm": gain(ks[10], QK_DIM),
        "w_o_mla": nrm(ks[11], (DEPTH, MLA_H * V_DIM, D_MODEL), (MLA_H * V_DIM) ** -0.5),
        "w_a2_fwd": nrm(ks[12], (DEPTH, GATE_RANK, GLA_H * GLA_DK), GATE_RANK ** -0.5),
        "b_a2_fwd": nrm(ks[13], (DEPTH, GLA_H * GLA_DK), 0.1),
        "w_a2_bwd": nrm(ks[14], (DEPTH, GATE_RANK, GLA_H * GLA_DK), GATE_RANK ** -0.5),
        "b_a2_bwd": nrm(ks[15], (DEPTH, GLA_H * GLA_DK), 0.1),
        "gla_o_norm": gain(ks[16], GLA_DV),
        "w_o_gla": nrm(ks[17], (DEPTH, GLA_H * GLA_DV, D_MODEL), (GLA_H * GLA_DV) ** -0.5),
        "w_out": nrm(ks[18], (DEPTH, D_MODEL, D_MODEL), D_MODEL ** -0.5),
        "ffn_norm": gain(ks[19], D_MODEL),
        "w_ffn_gate": nrm(ks[20], (DEPTH, D_MODEL, D_FF), D_MODEL ** -0.5),
        "w_ffn_up": nrm(ks[21], (DEPTH, D_MODEL, D_FF), D_MODEL ** -0.5),
        "w_ffn_down": nrm(ks[22], (DEPTH, D_FF, D_MODEL), D_FF ** -0.5),
    }


def reference(x_prompt, x_sample, meta_tokens, attn_norm, w_in, q_a_norm, w_uq, kv_a_norm, w_ukv,
              q_norm, k_norm, w_o_mla, w_a2_fwd, b_a2_fwd, w_a2_bwd, b_a2_bwd, gla_o_norm, w_o_gla,
              w_out, ffn_norm, w_ffn_gate, w_ffn_up, w_ffn_down):
    def encoder(x):
        b = x.shape[0]
        meta = jnp.broadcast_to(meta_tokens[None].astype(x.dtype), (b, N_META, D_MODEL))
        x = jnp.concatenate([meta, x], axis=1)
        for l in range(DEPTH):
            x = encoder_layer(x, attn_norm[l], w_in[l], q_a_norm[l], w_uq[l], kv_a_norm[l], w_ukv[l],
                              q_norm[l], k_norm[l], w_o_mla[l], w_a2_fwd[l], b_a2_fwd[l], w_a2_bwd[l],
                              b_a2_bwd[l], gla_o_norm[l], w_o_gla[l], w_out[l], ffn_norm[l],
                              w_ffn_gate[l], w_ffn_up[l], w_ffn_down[l])
        return x[:, N_META:]

    y_prompt = encoder(x_prompt)
    y_sample = encoder(x_sample)
    return (y_prompt, y_sample)
```

```cpp
#include <hip/hip_runtime.h>
#include <hip/hip_cooperative_groups.h>
#include <cstdio>
#include <cstdint>
namespace cg = cooperative_groups;

typedef unsigned short bf16_t;
typedef short bf16x8 __attribute__((ext_vector_type(8)));
typedef short s16x4 __attribute__((ext_vector_type(4)));
typedef float f32x4 __attribute__((ext_vector_type(4)));
typedef float f32x16 __attribute__((ext_vector_type(16)));
typedef unsigned u32x4 __attribute__((ext_vector_type(4)));
typedef unsigned u32x2 __attribute__((ext_vector_type(2)));
#define LAS __attribute__((address_space(3)))
#define SBAR() __builtin_amdgcn_sched_barrier(0)
__device__ __forceinline__ int TIDX() { int t = threadIdx.x; asm volatile("" : "+v"(t)); return t; }
__device__ __forceinline__ char* opaque(char* q) { size_t z = 0; asm volatile("" : "+s"(z)); return q + z; }
__device__ __forceinline__ int BIDX() { int b = blockIdx.x; asm volatile("" : "+s"(b)); return b; }

constexpr int DM = 1024, NREAL = 16384, RGMAX = NREAL + 512, DIN = 6240, NIN = 6400, DFF = 2816;
constexpr float EPS = 1e-6f;
constexpr int NTHR = 512;
constexpr int LDS_BYTES = 136 * 1024;

constexpr size_t al256(size_t x) { return (x + 255) / 256 * 256; }
constexpr size_t O_WIN = 0;
constexpr size_t O_WUQ = O_WIN + (size_t)NIN * 1024 * 2;
constexpr size_t O_WUKV = O_WUQ + (size_t)1536 * 768 * 2;
constexpr size_t O_WOM = O_WUKV + (size_t)2048 * 256 * 2;
constexpr size_t O_WOG = O_WOM + (size_t)1024 * 1024 * 2;
constexpr size_t O_WOUT = O_WOG + (size_t)1024 * 1024 * 2;
constexpr size_t O_WGU = O_WOUT + (size_t)1024 * 1024 * 2;
constexpr size_t O_WD = O_WGU + (size_t)5632 * 1024 * 2;
constexpr size_t O_G3 = O_WD + (size_t)1024 * DFF * 2;
constexpr size_t O_GP = O_G3 + (size_t)NREAL * 3072 * 2;
constexpr int NCHK = 258;
constexpr size_t GP_QT = 0;
constexpr size_t GP_KT = GP_QT + (size_t)NCHK * 4 * 2 * 64 * 128 * 2;
constexpr size_t GP_AM = GP_KT + (size_t)NCHK * 4 * 2 * 64 * 128 * 2;
constexpr size_t GP_VT = GP_AM + (size_t)NCHK * 4 * 2 * 64 * 64 * 2;
constexpr size_t GP_DC = GP_VT + (size_t)NCHK * 4 * 256 * 64 * 2;
constexpr size_t GP_U = GP_DC + (size_t)NCHK * 4 * 2 * 128 * 4;
constexpr size_t GP_D = GP_U + (size_t)16 * 4 * 2 * 128 * 256 * 4;
constexpr size_t GP_END = al256(GP_D + (size_t)16 * 4 * 2 * 128 * 4);
constexpr size_t O_V = O_GP + GP_END;
constexpr size_t O_QK = O_V + (size_t)RGMAX * 1024 * 2;
constexpr size_t O_OFB = O_QK + (size_t)RGMAX * 3072 * 2;
constexpr size_t O_OMLA = O_OFB + (size_t)NREAL * 2048 * 2;
constexpr size_t O_B4 = O_OMLA + (size_t)RGMAX * 1024 * 2;
constexpr size_t O_SMALL = O_B4 + (size_t)RGMAX * 256 * 2;
constexpr int S_ATTN = 0, S_QA = 1024, S_KVA = 1792, S_QN = 2048, S_KN = 2240, S_WAF = 2432, S_BAF = S_WAF + 8192, S_WAB = S_BAF + 512, S_BAB = S_WAB + 8192, S_GON = S_BAB + 512, S_FFN = S_GON + 256, S_END = S_FFN + 1024;
constexpr size_t O_BAR = al256(O_SMALL + (size_t)S_END * 4);
constexpr size_t WS_END = O_BAR + 3456 * 4;
constexpr size_t O_H = O_QK;
constexpr size_t O_B1 = O_QK + (size_t)RGMAX * 1024 * 2;
constexpr size_t O_B2 = O_OFB;
constexpr size_t O_KNR = O_OMLA;
constexpr size_t O_OGLA = O_GP + (size_t)NREAL * 1024 * 4;
constexpr size_t O_MIX = O_QK + (size_t)NREAL * 1024 * 2;
constexpr size_t O_H2 = O_QK + (size_t)NREAL * 2048 * 2;
constexpr size_t O_TMP = O_GP;
constexpr size_t O_ACT = O_GP;
static_assert(O_KNR + (size_t)RGMAX * 1024 * 2 <= O_B4 && (size_t)RGMAX * 1536 * 2 <= (size_t)NREAL * 1024 * 4, "overlay");
static_assert((size_t)RGMAX * 2048 * 2 <= (size_t)NREAL * 2048 * 2 + (size_t)RGMAX * 1024 * 2, "overlay b2");
static_assert((size_t)NREAL * 1024 * 4 + (size_t)NREAL * 1024 * 2 <= GP_END, "overlay ogla");
static_assert((size_t)NREAL * DFF * 2 <= GP_END && (size_t)NREAL * 1024 * 4 <= GP_END, "overlay act");
static_assert(WS_END <= (size_t)512 * 1024 * 1024, "workspace");

struct Params {
  const float *x_prompt, *x_sample, *meta, *attn_norm, *w_in, *q_a_norm, *w_uq, *kv_a_norm, *w_ukv, *q_norm, *k_norm, *w_o_mla,
      *w_a2_f, *b_a2_f, *w_a2_b, *b_a2_b, *gla_o_norm, *w_o_gla, *w_out, *ffn_norm, *w_gate, *w_up, *w_down;
  float* out; char* ws;
};

typedef __bf16 bf2_t __attribute__((ext_vector_type(2)));
typedef float f32x2_t __attribute__((ext_vector_type(2)));
__device__ __forceinline__ unsigned cvtpk(float lo, float hi) { f32x2_t v = {lo, hi}; bf2_t b = __builtin_convertvector(v, bf2_t); return *reinterpret_cast<unsigned*>(&b); }
__device__ __forceinline__ bf16_t f2bf(float f) { return (bf16_t)(cvtpk(f, 0.f) & 0xffffu); }
__device__ __forceinline__ float bf2f(bf16_t b) { return __uint_as_float(((unsigned)b) << 16); }
__device__ __forceinline__ float bflo(unsigned w) { return __uint_as_float(w << 16); }
__device__ __forceinline__ float bfhi(unsigned w) { return __uint_as_float(w & 0xffff0000u); }
__device__ __forceinline__ float wave_sum(float v) { for (int o = 32; o >= 1; o >>= 1) v += __shfl_xor(v, o); return v; }
__device__ __forceinline__ float sigmoidf_(float x) { return 1.f / (1.f + __expf(-x)); }
__device__ __forceinline__ void unpack8(u32x4 w, float* f) { f[0] = bflo(w.x); f[1] = bfhi(w.x); f[2] = bflo(w.y); f[3] = bfhi(w.y); f[4] = bflo(w.z); f[5] = bfhi(w.z); f[6] = bflo(w.w); f[7] = bfhi(w.w); }
__device__ __forceinline__ u32x4 pack8(const float* f) { u32x4 w; w.x = cvtpk(f[0], f[1]); w.y = cvtpk(f[2], f[3]); w.z = cvtpk(f[4], f[5]); w.w = cvtpk(f[6], f[7]); return w; }

template <class ColPtr>
__device__ void transpose_w(int K, long ld, bf16_t* dst, int Ndst, ColPtr colptr) {
  const int kb8 = K / 8; const long total = (long)(Ndst / 64) * kb8 * 64;
  for (long i = (long)BIDX() * NTHR + TIDX(); i < total; i += (long)gridDim.x * NTHR) {
    const int nl = (int)(i & 63); const long rest = i >> 6; const int kb = (int)(rest % kb8); const int nb = (int)(rest / kb8);
    const int n = nb * 64 + nl; const float* p = colptr(n);
    float v[8];
#pragma unroll
    for (int e = 0; e < 8; ++e) v[e] = p ? p[(long)(kb * 8 + e) * ld] : 0.f;
    *(u32x4*)(dst + (long)n * K + kb * 8) = pack8(v);
  }
}
__device__ void phase_weights(const Params& p) {
  char* ws = p.ws;
  { float* sm = (float*)(ws + O_SMALL); const int gi = BIDX() * NTHR + TIDX(), gs = gridDim.x * NTHR;
    for (int i = gi; i < 1024; i += gs) { sm[S_ATTN + i] = p.attn_norm[i]; sm[S_FFN + i] = p.ffn_norm[i]; }
    for (int i = gi; i < 768; i += gs) sm[S_QA + i] = p.q_a_norm[i];
    for (int i = gi; i < 256; i += gs) { sm[S_KVA + i] = p.kv_a_norm[i]; sm[S_GON + i] = p.gla_o_norm[i]; }
    for (int i = gi; i < 192; i += gs) { sm[S_QN + i] = p.q_norm[i]; sm[S_KN + i] = p.k_norm[i]; }
    for (int i = gi; i < 8192; i += gs) { sm[S_WAF + i] = p.w_a2_f[i]; sm[S_WAB + i] = p.w_a2_b[i]; }
    for (int i = gi; i < 512; i += gs) { sm[S_BAF + i] = p.b_a2_f[i]; sm[S_BAB + i] = p.b_a2_b[i]; } }
  { const float* w = p.w_in;
    transpose_w(1024, DIN, (bf16_t*)(ws + O_WIN), NIN, [=](int n) -> const float* {
      int o;
      if (n < 1024) o = n;
      else if (n < 2048) o = 1088 + (n - 1024);
      else if (n < 3072) o = 2112 + (n - 2048);
      else if (n < 4096) o = 3136 + (n - 3072);
      else if (n < 6144) o = 4192 + (n - 4096);
      else if (n < 6208) o = 1024 + (n - 6144);
      else if (n < 6240) o = 4160 + (n - 6208);
      else return nullptr;
      return w + o; }); }
  { const float* w = p.w_uq; transpose_w(768, 1536, (bf16_t*)(ws + O_WUQ), 1536, [=](int n) -> const float* { return w + n; }); }
  { const float* w = p.w_ukv; transpose_w(256, 2048, (bf16_t*)(ws + O_WUKV), 2048, [=](int n) -> const float* {
      return n < 1024 ? w + (n >> 7) * 256 + (n & 127) : w + ((n - 1024) >> 7) * 256 + 128 + (n & 127); }); }
  { const float* w = p.w_o_mla; transpose_w(1024, 1024, (bf16_t*)(ws + O_WOM), 1024, [=](int n) -> const float* { return w + n; }); }
  { const float* w = p.w_o_gla; transpose_w(1024, 1024, (bf16_t*)(ws + O_WOG), 1024, [=](int n) -> const float* { return w + n; }); }
  { const float* w = p.w_out; transpose_w(1024, 1024, (bf16_t*)(ws + O_WOUT), 1024, [=](int n) -> const float* { return w + n; }); }
  { const float* wg = p.w_gate; const float* wu = p.w_up;
    transpose_w(1024, DFF, (bf16_t*)(ws + O_WGU), 5632, [=](int n) -> const float* {
      const int q = n >> 3, i = n & 7; return i < 4 ? wg + q * 4 + i : wu + q * 4 + (i - 4); }); }
  { const float* w = p.w_down; transpose_w(DFF, 1024, (bf16_t*)(ws + O_WD), 1024, [=](int n) -> const float* { return w + n; }); }
}

struct Grp { const float* x; float* out; int nseq, Ls, RG; };
__device__ __forceinline__ Grp make_grp(const Params& p, int g) {
  Grp G; if (g == 0) { G.x = p.x_prompt; G.out = p.out; G.nseq = 2; G.Ls = 8192; }
  else { G.x = p.x_sample + (size_t)(g - 1) * NREAL * DM; G.out = p.out + (size_t)g * NREAL * DM; G.nseq = 1; G.Ls = 16384; }
  G.RG = NREAL + 256 * G.nseq; return G;
}

struct LArgs { char* ws; const float* x; float* out; const float* meta; int nseq; };
#define LPHASE __device__
LPHASE void rows_h(char* ws_, const float* x_, float* out_, const float* meta_, int nseq_) { struct { char* ws; const float* meta; } p; p.ws = ws_; p.meta = meta_; Grp G; G.x = x_; G.out = out_; G.nseq = nseq_; G.Ls = nseq_ == 2 ? 8192 : 16384; G.RG = NREAL + 256 * nseq_;
  const int tix = TIDX(), lane = tix & 63, gw = BIDX() * 8 + (tix >> 6), nw = gridDim.x * 8;
  bf16_t* h = (bf16_t*)(p.ws + O_H);
  for (int r = gw; r < G.RG; r += nw) {
    const float* xr = nullptr;
    if (r < NREAL) xr = G.x + (size_t)r * DM; else { const int i = (r - NREAL) & 255; if (i < 16) xr = p.meta + i * DM; }
    bf16_t* hr = h + (size_t)r * DM;
    if (!xr) {
#pragma unroll
      for (int q = 0; q < 4; ++q) *(u32x2*)(hr + q * 256 + lane * 4) = (u32x2){0u, 0u};
      continue; }
    f32x4 v[4]; float ss = 0.f;
#pragma unroll
    for (int q = 0; q < 4; ++q) { v[q] = *(const f32x4*)(xr + q * 256 + lane * 4); ss += v[q][0] * v[q][0] + v[q][1] * v[q][1] + v[q][2] * v[q][2] + v[q][3] * v[q][3]; }
    ss = wave_sum(ss); const float rs = rsqrtf(ss * (1.f / DM) + EPS);
#pragma unroll
    for (int q = 0; q < 4; ++q) { const f32x4 g = *(const f32x4*)((const float*)(p.ws + O_SMALL) + S_ATTN + q * 256 + lane * 4);
      u32x2 w; w.x = cvtpk(v[q][0] * rs * g[0], v[q][1] * rs * g[1]); w.y = cvtpk(v[q][2] * rs * g[2], v[q][3] * rs * g[3]);
      *(u32x2*)(hr + q * 256 + lane * 4) = w; }
  }
}
LPHASE void rows_h2(char* ws_, const float* x_, float* out_, const float* meta_, int nseq_) { struct { char* ws; const float* meta; } p; p.ws = ws_; p.meta = meta_; Grp G; G.x = x_; G.out = out_; G.nseq = nseq_; G.Ls = nseq_ == 2 ? 8192 : 16384; G.RG = NREAL + 256 * nseq_;
  const int tix = TIDX(), lane = tix & 63, gw = BIDX() * 8 + (tix >> 6), nw = gridDim.x * 8;
  bf16_t* h = (bf16_t*)(p.ws + O_H2);
  for (int r = gw; r < NREAL; r += nw) {
    const float* xr = G.out + (size_t)r * DM; bf16_t* hr = h + (size_t)r * DM;
    f32x4 v[4]; float ss = 0.f;
#pragma unroll
    for (int q = 0; q < 4; ++q) { v[q] = *(const f32x4*)(xr + q * 256 + lane * 4); ss += v[q][0] * v[q][0] + v[q][1] * v[q][1] + v[q][2] * v[q][2] + v[q][3] * v[q][3]; }
    ss = wave_sum(ss); const float rs = rsqrtf(ss * (1.f / DM) + EPS);
#pragma unroll
    for (int q = 0; q < 4; ++q) { const f32x4 g = *(const f32x4*)((const float*)(p.ws + O_SMALL) + S_FFN + q * 256 + lane * 4);
      u32x2 w; w.x = cvtpk(v[q][0] * rs * g[0], v[q][1] * rs * g[1]); w.y = cvtpk(v[q][2] * rs * g[2], v[q][3] * rs * g[3]);
      *(u32x2*)(hr + q * 256 + lane * 4) = w; }
  }
}
LPHASE void rows_cnorm(char* ws_, const float* x_, float* out_, const float* meta_, int nseq_) { struct { char* ws; const float* meta; } p; p.ws = ws_; p.meta = meta_; Grp G; G.x = x_; G.out = out_; G.nseq = nseq_; G.Ls = nseq_ == 2 ? 8192 : 16384; G.RG = NREAL + 256 * nseq_;
  const int tix = TIDX(), lane = tix & 63, gw = BIDX() * 8 + (tix >> 6), nw = gridDim.x * 8;
  bf16_t* b1 = (bf16_t*)(p.ws + O_B1);
  const int nmeta8 = 32 * nseq_;
  if (gw < nmeta8) return;
  for (int r = gw - nmeta8; r < G.RG; r += nw - nmeta8) {
    bf16_t* br = b1 + (size_t)r * 1024;
    float a[8], b[8]; unpack8(*(const u32x4*)(br + lane * 8), a); unpack8(*(const u32x4*)(br + 512 + lane * 8), b);
    float sa = 0.f, sb = 0.f;
#pragma unroll
    for (int e = 0; e < 8; ++e) { sa += a[e] * a[e]; sb += b[e] * b[e]; }
    float sq = sa + (lane < 32 ? sb : 0.f), skv = (lane < 32 ? 0.f : sb);
    sq = wave_sum(sq); skv = wave_sum(skv);
    const float rq = rsqrtf(sq * (1.f / 768.f) + EPS), rkv = rsqrtf(skv * (1.f / 256.f) + EPS);
    const float* smq = (const float*)(p.ws + O_SMALL) + S_QA; const float* gb = lane < 32 ? smq + 512 + lane * 8 : (const float*)(p.ws + O_SMALL) + S_KVA + (lane * 8 - 256); const float rb = lane < 32 ? rq : rkv;
#pragma unroll
    for (int e = 0; e < 8; ++e) { a[e] *= rq * smq[lane * 8 + e]; b[e] *= rb * gb[e]; }
    *(u32x4*)(br + lane * 8) = pack8(a); *(u32x4*)(br + 512 + lane * 8) = pack8(b);
  }
}
LPHASE void rows_qk(char* ws_, const float* x_, float* out_, const float* meta_, int nseq_) { struct { char* ws; const float* meta; } p; p.ws = ws_; p.meta = meta_; Grp G; G.x = x_; G.out = out_; G.nseq = nseq_; G.Ls = nseq_ == 2 ? 8192 : 16384; G.RG = NREAL + 256 * nseq_;
  const int tix = TIDX(), lane = tix & 63, gw = BIDX() * 8 + (tix >> 6), nw = gridDim.x * 8;
  const bf16_t* qraw = (const bf16_t*)G.out; const bf16_t* knr = (const bf16_t*)(p.ws + O_KNR); const bf16_t* b4 = (const bf16_t*)(p.ws + O_B4);
  bf16_t* Q = (bf16_t*)(p.ws + O_QK); bf16_t* Kb = Q + (size_t)RGMAX * 1536;
  const int ri = lane & 31;
  const float inv = __expf(-(float)(2 * ri) * (1.f / 64.f) * 9.210340371976184f);
  const float* smn = (const float*)(p.ws + O_SMALL);
  const float qn0 = smn[S_QN + lane], qn1 = smn[S_QN + 64 + lane], qn2 = smn[S_QN + 128 + lane];
  const float kn0 = smn[S_KN + lane], kn1 = smn[S_KN + 64 + lane], kn2 = smn[S_KN + 128 + lane];
  for (int r = gw; r < G.RG; r += nw) {
    int pos; if (r < NREAL) pos = 16 + (r % G.Ls); else pos = (r - NREAL) & 255;
    float sn, cs; sincosf((float)pos * inv, &sn, &cs);
    const float kr = bf2f(b4[(size_t)r * 256 + lane]);
    for (int h = 0; h < 8; ++h) {
      { const bf16_t* s = knr + (size_t)r * 1024 + h * 128; float e0 = bf2f(s[lane]), e1 = bf2f(s[64 + lane]), e2 = kr;
        float ss = wave_sum(e0 * e0 + e1 * e1 + e2 * e2); const float rs = rsqrtf(ss * (1.f / 192.f) + EPS);
        e0 *= rs * kn0; e1 *= rs * kn1; e2 *= rs * kn2; const float pr = __shfl_xor(e2, 32);
        const float o2 = lane < 32 ? e2 * cs - pr * sn : e2 * cs + pr * sn;
        bf16_t* d = Kb + (size_t)r * 1536 + h * 192; d[lane] = f2bf(e0); d[64 + lane] = f2bf(e1); d[128 + lane] = f2bf(o2); }
    }
  }
}
LPHASE void rows_ogla(char* ws_, const float* x_, float* out_, const float* meta_, int nseq_) { struct { char* ws; const float* meta; } p; p.ws = ws_; p.meta = meta_; Grp G; G.x = x_; G.out = out_; G.nseq = nseq_; G.Ls = nseq_ == 2 ? 8192 : 16384; G.RG = NREAL + 256 * nseq_;
  const int tix = TIDX(), lane = tix & 63, gw = BIDX() * 8 + (tix >> 6), nw = gridDim.x * 8;
  const bf16_t* of = (const bf16_t*)(p.ws + O_OFB); const bf16_t* ob = of + (size_t)NREAL * 1024;
  const bf16_t* g3 = (const bf16_t*)(p.ws + O_G3); bf16_t* og = (bf16_t*)(p.ws + O_OGLA);
  for (int r = gw; r < NREAL; r += nw) {
    float a[16], b[8];
    unpack8(*(const u32x4*)(of + (size_t)r * 1024 + lane * 16), a); unpack8(*(const u32x4*)(of + (size_t)r * 1024 + lane * 16 + 8), a + 8);
    unpack8(*(const u32x4*)(ob + (size_t)r * 1024 + lane * 16), b);
#pragma unroll
    for (int e = 0; e < 8; ++e) a[e] += b[e];
    unpack8(*(const u32x4*)(ob + (size_t)r * 1024 + lane * 16 + 8), b);
#pragma unroll
    for (int e = 0; e < 8; ++e) a[8 + e] += b[e];
    float ss = 0.f;
#pragma unroll
    for (int e = 0; e < 16; ++e) ss += a[e] * a[e];
    ss += __shfl_xor(ss, 1); ss += __shfl_xor(ss, 2); ss += __shfl_xor(ss, 4); ss += __shfl_xor(ss, 8);
    const float rs = rsqrtf(ss * (1.f / 256.f) + EPS);
    float gg[16]; unpack8(*(const u32x4*)(g3 + (size_t)r * 3072 + lane * 16), gg); unpack8(*(const u32x4*)(g3 + (size_t)r * 3072 + lane * 16 + 8), gg + 8);
    const float* gn = (const float*)(p.ws + O_SMALL) + S_GON + ((lane * 16) & 255);
#pragma unroll
    for (int e = 0; e < 16; ++e) a[e] = a[e] * rs * gn[e] * (gg[e] * sigmoidf_(gg[e]));
    *(u32x4*)(og + (size_t)r * 1024 + lane * 16) = pack8(a); *(u32x4*)(og + (size_t)r * 1024 + lane * 16 + 8) = pack8(a + 8);
  }
}

constexpr int BM = 256, BK = 64, HALF = 128, HTB = HALF * BK * 2, NXCD = 8, WGM = 4;
__device__ __forceinline__ int lds_byte(int r, int c) { const int st = (r >> 4) * 2 + (c >> 5), rr = r & 15, cc = c & 31, ob = rr * 64 + cc * 2; return st * 1024 + (ob ^ (((ob >> 9) & 1) << 5)); }
__device__ __forceinline__ void stage_rc(int b, int& R, int& C) { const int st = b / 1024, sb = b % 1024, swz = sb ^ (((sb >> 9) & 1) << 5); R = (st >> 1) * 16 + swz / 64; C = (st & 1) * 32 + (swz % 64) / 2; }
__device__ __forceinline__ int perm32(int rho) { const int n = rho >> 4, i = rho & 15; return 8 * (i >> 2) + 4 * n + (i & 3); }
struct Unit { int pm, pn, w; };
struct Gemm { const bf16_t* A; const bf16_t* Bt; int lda, ldb, M, N, K; const bf16_t* A2; const bf16_t* Bt2; };
struct StaticOrder {
  int nM, nN, nwg, G, c, ntot;
  __device__ void init(int M, int N, int G_, int c_, bool dual) { nM = M / BM; nN = N / BM; nwg = nM * nN; ntot = dual ? 2 * nwg : nwg; G = G_; c = c_; }
  __device__ bool next(int i, Unit& u) const {
    const long L = (long)i * G + c; if (L >= ntot) return false;
    u.w = L >= nwg ? 1 : 0;
    int wgid = (int)(L - (u.w ? nwg : 0)); { const int q = nwg / NXCD, r = nwg % NXCD, xcd = wgid % NXCD, off = wgid / NXCD; wgid = (xcd < r ? xcd * (q + 1) : r * (q + 1) + (xcd - r) * q) + off; }
    const int nig = WGM * nN, gid = wgid / nig, fm = gid * WGM, gsz = (nM - fm) < WGM ? (nM - fm) : WGM;
    u.pm = fm + ((wgid % nig) % gsz); u.pn = (wgid % nig) / gsz; return true;
  }
};
template <class Epi>
__device__ __forceinline__ void gemm_phase(LAS unsigned char* lds, const Gemm g, const Epi& E) {
  int tid_ = threadIdx.x; asm volatile("" : "+v"(tid_));
  const int tid = tid_, wid = __builtin_amdgcn_readfirstlane(tid >> 6), lane = tid & 63, wr = wid >> 2, wc = wid & 3, fr = lane & 15, fq = lane >> 4;
  const int K = g.K, nt = K / BK;
  StaticOrder S; S.init(g.M, g.N, gridDim.x, blockIdx.x, g.A2 != nullptr);
  unsigned voffA[2], voffB[2];
#pragma unroll
  for (int i = 0; i < 2; ++i) { int R, C; stage_rc(tid * 16 + i * 8192, R, C); const int Rb = (R & ~31) + perm32(R & 31);
    voffA[i] = (unsigned)(R * g.lda + C) * 2u; voffB[i] = (unsigned)(Rb * g.ldb + C) * 2u; }
  const size_t kstep = (size_t)(BK * 2);
  const size_t hstepA = (size_t)HALF * g.lda * 2, hstepB = (size_t)HALF * g.ldb * 2;
  const size_t tstepA = 2 * hstepA, tstepB = 2 * hstepB;
  const unsigned ldsw = (unsigned)wid * 1024u;
  const int aoff = lds_byte(wr * 64 + fr, fq * 8), boff = lds_byte(wc * 32 + fr, fq * 8);
#define PG8_SA(b, h) (((b) * 2 + (h)) * HTB)
#define PG8_SB(b, h) ((4 + (b) * 2 + (h)) * HTB)
#define PG8_STAGE(bufoff, gbase, voff) do { _Pragma("unroll") for (int _i = 0; _i < 2; ++_i) \
    __builtin_amdgcn_global_load_lds((const unsigned*)((const char*)(gbase) + (voff)[_i]), (LAS unsigned*)(lds + (bufoff) + ldsw + _i * 8192), 16, 0, 0); } while (0)
#define PG8_LDA(dst, b, h) do { _Pragma("unroll") for (int m = 0; m < 4; ++m) _Pragma("unroll") for (int k = 0; k < 2; ++k) dst[m][k] = *(const LAS bf16x8*)(lds + PG8_SA(b, h) + aoff + m * 2048 + k * 1024); } while (0)
#define PG8_LDB(dst, b, h) do { _Pragma("unroll") for (int n = 0; n < 2; ++n) _Pragma("unroll") for (int k = 0; k < 2; ++k) dst[n][k] = *(const LAS bf16x8*)(lds + PG8_SB(b, h) + boff + n * 2048 + k * 1024); } while (0)
#define PG8_MMA(ai, bj, At, Bt) do { __builtin_amdgcn_s_setprio(1); _Pragma("unroll") for (int m = 0; m < 4; ++m) _Pragma("unroll") for (int n = 0; n < 2; ++n) _Pragma("unroll") for (int k = 0; k < 2; ++k) \
    acc[ai][bj][m][n] = __builtin_amdgcn_mfma_f32_16x16x32_bf16(Bt[n][k], At[m][k], acc[ai][bj][m][n], 0, 0, 0); __builtin_amdgcn_s_setprio(0); } while (0)
#define PG8_WAIT_V(n) asm volatile("s_waitcnt vmcnt(" #n ")" ::: "memory")
#define PG8_WAIT_L(n) asm volatile("s_waitcnt lgkmcnt(" #n ")" ::: "memory")
#define PG8_BAR __builtin_amdgcn_s_barrier()
#define PG8_SCHED __builtin_amdgcn_sched_barrier(0)
  Unit cur, nxt; int ui = 0;
  if (!S.next(0, cur)) return;
  f32x4 acc[2][2][4][2];
#pragma unroll
  for (int a = 0; a < 2; ++a)
#pragma unroll
    for (int b = 0; b < 2; ++b)
#pragma unroll
      for (int m = 0; m < 4; ++m)
#pragma unroll
        for (int n = 0; n < 2; ++n) acc[a][b][m][n] = (f32x4){0.f, 0.f, 0.f, 0.f};
  bf16x8 At[4][2], B0[2][2], B1[2][2];
  const char* cA = (const char*)(cur.w ? g.A2 : g.A) + (size_t)cur.pm * tstepA; const char* cB = (const char*)(cur.w ? g.Bt2 : g.Bt) + (size_t)cur.pn * tstepB;
  PG8_STAGE(PG8_SB(0, 0), cB, voffB); PG8_STAGE(PG8_SA(0, 0), cA, voffA); PG8_STAGE(PG8_SB(0, 1), cB + hstepB, voffB); PG8_STAGE(PG8_SA(0, 1), cA + hstepA, voffA);
  if (wr == 1) PG8_BAR;
  PG8_WAIT_V(4); PG8_BAR;
  PG8_STAGE(PG8_SB(1, 0), cB + kstep, voffB); PG8_STAGE(PG8_SA(1, 0), cA + kstep, voffA); PG8_STAGE(PG8_SB(1, 1), cB + hstepB + kstep, voffB);
  PG8_WAIT_V(6); PG8_BAR;
  for (;;) {
    const bool has_next = S.next(ui + 1, nxt);
    const char* nA = has_next ? (const char*)(nxt.w ? g.A2 : g.A) + (size_t)nxt.pm * tstepA : cA; const char* nB = has_next ? (const char*)(nxt.w ? g.Bt2 : g.Bt) + (size_t)nxt.pn * tstepB : cB;
    for (int t = 0; t < nt; t += 2) {
      const bool last = (t == nt - 2);
      const char* a1 = cA + (size_t)(t + 1) * kstep;
      const char* a2 = last ? nA : cA + (size_t)(t + 2) * kstep; const char* b2 = last ? nB : cB + (size_t)(t + 2) * kstep;
      const char* a3 = a2 + kstep; const char* b3 = b2 + kstep;
      PG8_LDB(B0, 0, 0); PG8_SCHED; PG8_LDA(At, 0, 0); PG8_STAGE(PG8_SA(1, 1), a1 + hstepA, voffA);
      PG8_WAIT_L(8); PG8_BAR; PG8_WAIT_L(0); PG8_MMA(0, 0, At, B0); PG8_BAR; PG8_SCHED;
      PG8_LDB(B1, 0, 1); PG8_STAGE(PG8_SB(0, 0), b2, voffB);
      PG8_BAR; PG8_WAIT_L(0); PG8_MMA(0, 1, At, B1); PG8_BAR;
      PG8_LDA(At, 0, 1); PG8_STAGE(PG8_SA(0, 0), a2, voffA);
      PG8_BAR; PG8_WAIT_L(0); PG8_MMA(1, 0, At, B0); PG8_BAR; PG8_SCHED;
      PG8_STAGE(PG8_SB(0, 1), b2 + hstepB, voffB);
      PG8_WAIT_V(6); PG8_BAR; PG8_MMA(1, 1, At, B1); PG8_BAR;
      PG8_LDB(B0, 1, 0); PG8_SCHED; PG8_LDA(At, 1, 0); PG8_STAGE(PG8_SA(0, 1), a2 + hstepA, voffA);
      PG8_WAIT_L(8); PG8_BAR; PG8_WAIT_L(0); PG8_MMA(0, 0, At, B0); PG8_BAR; PG8_SCHED;
      PG8_LDB(B1, 1, 1); PG8_STAGE(PG8_SB(1, 0), b3, voffB);
      PG8_BAR; PG8_WAIT_L(0); PG8_MMA(0, 1, At, B1); PG8_BAR;
      PG8_LDA(At, 1, 1); PG8_STAGE(PG8_SA(1, 0), a3, voffA);
      PG8_BAR; PG8_WAIT_L(0); PG8_MMA(1, 0, At, B0); PG8_BAR; PG8_SCHED;
      PG8_STAGE(PG8_SB(1, 1), b3 + hstepB, voffB);
      PG8_WAIT_V(6); PG8_BAR; PG8_MMA(1, 1, At, B1); PG8_BAR;
    }
    {
#pragma unroll
      for (int ai = 0; ai < 2; ++ai)
#pragma unroll
        for (int m = 0; m < 4; ++m)
#pragma unroll
          for (int bj = 0; bj < 2; ++bj)
          { E.st2(cur.w, cur.pm * BM + ai * HALF + wr * 64 + m * 16 + fr, cur.pn * BM + bj * HALF + wc * 32 + 8 * fq, acc[ai][bj][m][0], acc[ai][bj][m][1]); if (bj == 1 && (m & 1)) asm volatile("" ::: "memory"); }
    }
    if (!has_next) break;
#pragma unroll
    for (int a = 0; a < 2; ++a)
#pragma unroll
      for (int b = 0; b < 2; ++b)
#pragma unroll
        for (int m = 0; m < 4; ++m)
#pragma unroll
          for (int n = 0; n < 2; ++n) acc[a][b][m][n] = (f32x4){0.f, 0.f, 0.f, 0.f};
    cur = nxt; cA = nA; cB = nB; ++ui;
  }
  PG8_WAIT_V(0);
  if (wr == 0) PG8_BAR;
  PG8_BAR;
#undef PG8_SA
#undef PG8_SB
#undef PG8_STAGE
#undef PG8_LDA
#undef PG8_LDB
#undef PG8_MMA
#undef PG8_WAIT_V
#undef PG8_WAIT_L
#undef PG8_BAR
#undef PG8_SCHED
}

__device__ __forceinline__ u32x4 pk8(f32x4 a, f32x4 b) { u32x4 w; w.x = cvtpk(a[0], a[1]); w.y = cvtpk(a[2], a[3]); w.z = cvtpk(b[0], b[1]); w.w = cvtpk(b[2], b[3]); return w; }
struct EpiInproj { bf16_t *b1, *b2, *g3, *b4;
  __device__ __forceinline__ void st(int r, int c, f32x4 v0, f32x4 v1) const {
    const u32x4 w = pk8(v0, v1);
    if (c < 1024) *(u32x4*)(b1 + (size_t)r * 1024 + c) = w;
    else if (c < 3072) *(u32x4*)(b2 + (size_t)r * 2048 + (c - 1024)) = w;
    else if (c < 6144) { if (r < NREAL) *(u32x4*)(g3 + (size_t)r * 3072 + (c - 3072)) = w; }
    else *(u32x4*)(b4 + (size_t)r * 256 + (c - 6144)) = w; } };
struct EpiBf16 { bf16_t* o; int ld;
  __device__ __forceinline__ void st(int r, int c, f32x4 v0, f32x4 v1) const { *(u32x4*)(o + (size_t)r * ld + c) = pk8(v0, v1); } };
struct EpiKV { bf16_t *kn, *v;
  __device__ __forceinline__ void st(int r, int c, f32x4 v0, f32x4 v1) const {
    if (c < 1024) *(u32x4*)(kn + (size_t)r * 1024 + c) = pk8(v0, v1); else *(u32x4*)(v + (size_t)r * 1024 + (c - 1024)) = pk8(v0, v1); } };
struct EpiGateA { const bf16_t* g3; bf16_t* tmp;
  __device__ __forceinline__ void st(int r, int c, f32x4 v0, f32x4 v1) const {
    float g[8]; unpack8(*(const u32x4*)(g3 + (size_t)r * 3072 + 1024 + c), g);
    f32x4 a, b;
#pragma unroll
    for (int e = 0; e < 4; ++e) { a[e] = v0[e] * sigmoidf_(g[e]); b[e] = v1[e] * sigmoidf_(g[4 + e]); }
    *(u32x4*)(tmp + (size_t)r * 1024 + c) = pk8(a, b); } };
struct EpiGateB { const bf16_t* g3; const bf16_t* tmp; bf16_t* m;
  __device__ __forceinline__ void st(int r, int c, f32x4 v0, f32x4 v1) const {
    float g[8]; unpack8(*(const u32x4*)(g3 + (size_t)r * 3072 + 2048 + c), g);
    float t[8]; unpack8(*(const u32x4*)(tmp + (size_t)r * 1024 + c), t);
    f32x4 a = (f32x4){t[0], t[1], t[2], t[3]}, b = (f32x4){t[4], t[5], t[6], t[7]};
#pragma unroll
    for (int e = 0; e < 4; ++e) { a[e] += v0[e] * sigmoidf_(g[e]); b[e] += v1[e] * sigmoidf_(g[4 + e]); }
    *(u32x4*)(m + (size_t)r * 1024 + c) = pk8(a, b); } };
struct EpiX1 { const float* x; float* out;
  __device__ __forceinline__ void st(int r, int c, f32x4 v0, f32x4 v1) const {
    const f32x4 a = *(const f32x4*)(x + (size_t)r * 1024 + c), b = *(const f32x4*)(x + (size_t)r * 1024 + c + 4);
    *(f32x4*)(out + (size_t)r * 1024 + c) = a + v0; *(f32x4*)(out + (size_t)r * 1024 + c + 4) = b + v1; } };
struct EpiFfnUp { bf16_t* act;
  __device__ __forceinline__ void st(int r, int c, f32x4 v0, f32x4 v1) const {
    float o[4];
#pragma unroll
    for (int e = 0; e < 4; ++e) o[e] = v0[e] * sigmoidf_(v0[e]) * v1[e];
    u32x2 w; w.x = cvtpk(o[0], o[1]); w.y = cvtpk(o[2], o[3]); *(u32x2*)(act + (size_t)r * DFF + (c >> 1)) = w; } };
struct EpiFfnDown { float* out;
  __device__ __forceinline__ void st(int r, int c, f32x4 v0, f32x4 v1) const {
    float* o = out + (size_t)r * 1024 + c; const f32x4 a = *(const f32x4*)o, b = *(const f32x4*)(o + 4);
    *(f32x4*)o = a + v0; *(f32x4*)(o + 4) = b + v1; } };

constexpr int LDQ = 1536, LDK = 1536, LDV = 1024, LDO = 1024;
constexpr int SHM_V = 64 * 128 * 2, SHM_K = 64 * 192 * 2;
constexpr float ATT_SCALE = 0.07216878364870322f;
constexpr float ATT_THR = 8.f;
#define KSWZ(row, colB) ((row) * 384 + ((colB) ^ (((row) & 7) << 4)))
__device__ __forceinline__ int crow(int r, int hi) { return (r & 3) + 8 * (r >> 2) + 4 * hi; }
__device__ __forceinline__ void partialSM(f32x16& p0, f32x16& p1, float& m_reg, float& mn, float& alpha) {
  constexpr float C = ATT_SCALE * 1.4426950408889634f;
  float pmax = p0[0];
#pragma unroll
  for (int r = 1; r < 16; ++r) pmax = fmaxf(pmax, p0[r]);
#pragma unroll
  for (int r = 0; r < 16; ++r) pmax = fmaxf(pmax, p1[r]);
  { auto rr = __builtin_amdgcn_permlane32_swap(__float_as_uint(pmax), __float_as_uint(pmax), false, false);
    pmax = fmaxf(__uint_as_float(rr[0]), __uint_as_float(rr[1])); }
  if (__builtin_expect(__all(pmax - m_reg <= ATT_THR / ATT_SCALE), 1)) { mn = m_reg; alpha = 1.f; }
  else { mn = fmaxf(m_reg, pmax); alpha = __builtin_amdgcn_exp2f((m_reg - mn) * C); m_reg = mn; }
  const float mnC = -mn * C;
#pragma unroll
  for (int r = 0; r < 16; ++r) p0[r] = fmaf(p0[r], C, mnC);
#pragma unroll
  for (int r = 0; r < 16; ++r) p1[r] = fmaf(p1[r], C, mnC);
#pragma unroll
  for (int r = 0; r < 16; ++r) p0[r] = __builtin_amdgcn_exp2f(p0[r]);
}
__device__ __forceinline__ void finishSM(f32x16& p0, f32x16& p1, float alpha, float& l_reg, bf16x8& pa0, bf16x8& pa1, bf16x8& pa2, bf16x8& pa3) {
#pragma unroll
  for (int r = 0; r < 16; ++r) p1[r] = __builtin_amdgcn_exp2f(p1[r]);
  float ps = 0;
#pragma unroll
  for (int r = 0; r < 16; ++r) ps += p0[r];
#pragma unroll
  for (int r = 0; r < 16; ++r) ps += p1[r];
  { auto rr = __builtin_amdgcn_permlane32_swap(__float_as_uint(ps), __float_as_uint(ps), false, false);
    ps = __uint_as_float(rr[0]) + __uint_as_float(rr[1]); }
  l_reg = l_reg * alpha + ps;
#define PK4(P, BASE, OUT) do { unsigned a0 = cvtpk(P[BASE + 0], P[BASE + 1]), a1 = cvtpk(P[BASE + 2], P[BASE + 3]);   \
    unsigned b0 = cvtpk(P[BASE + 4], P[BASE + 5]), b1 = cvtpk(P[BASE + 6], P[BASE + 7]);                              \
    auto r0 = __builtin_amdgcn_permlane32_swap(a0, b0, false, false); auto r1 = __builtin_amdgcn_permlane32_swap(a1, b1, false, false); \
    u32x4 w = {r0[0], r1[0], r0[1], r1[1]}; OUT = *reinterpret_cast<bf16x8*>(&w); } while (0)
  PK4(p0, 0, pa0); PK4(p0, 8, pa1); PK4(p1, 0, pa2); PK4(p1, 8, pa3);
#undef PK4
}
__device__ __forceinline__ void qkt(f32x16& p0, f32x16& p1, const char* Ks, const bf16x8* qr, const char* qx, int r32, int hi, int mode) {
  p0 = f32x16{}; p1 = f32x16{};
#pragma unroll
  for (int d0 = 0; d0 < 12; ++d0) { const int cb = (d0 * 16 + hi * 8) * 2;
    bf16x8 b0 = *reinterpret_cast<const bf16x8*>(Ks + KSWZ(r32, cb));
    bf16x8 b1 = *reinterpret_cast<const bf16x8*>(Ks + KSWZ(32 + r32, cb));
    const bf16x8 qf = d0 < 8 ? qr[d0 < 8 ? d0 : 0] : *reinterpret_cast<const bf16x8*>(qx + (d0 - 8) * 1024);
    p0 = __builtin_amdgcn_mfma_f32_32x32x16_bf16(b0, qf, p0, 0, 0, 0);
    p1 = __builtin_amdgcn_mfma_f32_32x32x16_bf16(b1, qf, p1, 0, 0, 0); }
  if (mode != 0) {
    constexpr float NEG = -1e30f;
#pragma unroll
    for (int r = 0; r < 16; ++r) p1[r] = NEG;
#pragma unroll
    for (int r = 8; r < 16; ++r) p0[r] = NEG;
    if (mode == 2) {
#pragma unroll
      for (int r = 0; r < 8; ++r) p0[r] = NEG; }
  }
}
__device__ __forceinline__ int v_st(int k, int c) { const int kk = (k & ~0xC) | ((k & 4) << 1) | ((k & 8) >> 1); return ((kk >> 3) * 4 + (c >> 5)) * 512 + ((kk & 7) * 32 + (c & 31)) * 2; }
__device__ __forceinline__ int v_rd_base(int lane) { return ((lane & 3) << 3) | (((lane >> 2) & 3) << 6) | (((lane >> 4) & 1) << 5) | (((lane >> 5) & 1) << 8); }
constexpr int v_rd_off(int d0, int ks, int half) { return d0 * 512 + ks * 4096 + half * 2048; }
template <int OFF> __device__ __forceinline__ s16x4 tr_read(int vb) {
  s16x4 r; asm volatile("ds_read_b64_tr_b16 %0, %1 offset:%2" : "=&v"(r) : "v"(vb), "i"(OFF) : "memory"); return r;
}
template <int D0> __device__ __forceinline__ void pv_one(f32x16& od, int vb, bf16x8 pa0, bf16x8 pa1, bf16x8 pa2, bf16x8 pa3) {
  const s16x4 l0 = tr_read<v_rd_off(D0, 0, 0)>(vb), h0 = tr_read<v_rd_off(D0, 0, 1)>(vb), l1 = tr_read<v_rd_off(D0, 1, 0)>(vb), h1 = tr_read<v_rd_off(D0, 1, 1)>(vb);
  const s16x4 l2 = tr_read<v_rd_off(D0, 2, 0)>(vb), h2 = tr_read<v_rd_off(D0, 2, 1)>(vb), l3 = tr_read<v_rd_off(D0, 3, 0)>(vb), h3 = tr_read<v_rd_off(D0, 3, 1)>(vb);
  asm volatile("s_waitcnt lgkmcnt(0)" ::: "memory"); SBAR();
#define PK(L, H) (bf16x8){L[0], L[1], L[2], L[3], H[0], H[1], H[2], H[3]}
  od = __builtin_amdgcn_mfma_f32_32x32x16_bf16(pa0, PK(l0, h0), od, 0, 0, 0);
  od = __builtin_amdgcn_mfma_f32_32x32x16_bf16(pa1, PK(l1, h1), od, 0, 0, 0);
  od = __builtin_amdgcn_mfma_f32_32x32x16_bf16(pa2, PK(l2, h2), od, 0, 0, 0);
  od = __builtin_amdgcn_mfma_f32_32x32x16_bf16(pa3, PK(l3, h3), od, 0, 0, 0);
#undef PK
}
__device__ __forceinline__ void pv_d0(f32x16* o, int vb, bf16x8 pa0, bf16x8 pa1, bf16x8 pa2, bf16x8 pa3) {
  pv_one<0>(o[0], vb, pa0, pa1, pa2, pa3); pv_one<1>(o[1], vb, pa0, pa1, pa2, pa3); pv_one<2>(o[2], vb, pa0, pa1, pa2, pa3); pv_one<3>(o[3], vb, pa0, pa1, pa2, pa3);
}
__device__ __forceinline__ void attn_body(const bf16_t* __restrict__ Qb, const bf16_t* __restrict__ Kh, const bf16_t* __restrict__ Vh,
                                          bf16_t* __restrict__ Ob, int krow0, int mrow0, int ntr, char* lds, int pos0, const float* __restrict__ qn) {
  int tid_ = threadIdx.x; asm volatile("" : "+v"(tid_));
  const int tid = tid_, wid = tid >> 6, lane = tid & 63, r32 = lane & 31, hi = lane >> 5;
  char* V_lds = lds; char* K_lds = lds + 2 * SHM_V;
  float* wsf = (float*)(lds + 2 * SHM_V + 2 * SHM_K) + wid * 64; float* li_l = wsf; float* al_l = wsf + 32;
  bf16x8 qr[8];
  char* qx = lds + 2 * SHM_V + 2 * SHM_K + 2048 + wid * 4096 + lane * 16;
  {
    float csv[16], snv[16];
    { const float posf = (float)(pos0 + wid * 32 + r32);
#pragma unroll
      for (int k = 0; k < 16; ++k) { const int i = 16 * (k >> 3) + 8 * hi + (k & 7);
        const float inv = __expf(-(float)(2 * i) * (1.f / 64.f) * 9.210340371976184f);
        sincosf(posf * inv, &snv[k], &csv[k]); asm volatile("" : "+v"(snv[k]), "+v"(csv[k])); } }
    const bf16_t* Qw = Qb + (long)(wid * 32 + r32) * LDQ + hi * 8;
    float xf[12][8]; float ss = 0.f;
#pragma unroll
    for (int d0 = 0; d0 < 12; ++d0) { unpack8(*reinterpret_cast<const u32x4*>(Qw + d0 * 16), xf[d0]);
#pragma unroll
      for (int e = 0; e < 8; ++e) ss += xf[d0][e] * xf[d0][e]; }
    ss += __shfl_xor(ss, 32);
    const float rs = rsqrtf(ss * (1.f / 192.f) + EPS);
#pragma unroll
    for (int d0 = 0; d0 < 12; ++d0) { const f32x4 g0 = *(const f32x4*)(qn + d0 * 16 + hi * 8), g1 = *(const f32x4*)(qn + d0 * 16 + hi * 8 + 4);
#pragma unroll
      for (int e = 0; e < 4; ++e) { xf[d0][e] *= rs * g0[e]; xf[d0][4 + e] *= rs * g1[e]; } }
#pragma unroll
    for (int dd = 0; dd < 2; ++dd)
#pragma unroll
      for (int e = 0; e < 8; ++e) { const float sn = snv[8 * dd + e], cs = csv[8 * dd + e];
        const float x1 = xf[8 + dd][e], x2 = xf[10 + dd][e];
        xf[8 + dd][e] = x1 * cs - x2 * sn; xf[10 + dd][e] = x2 * cs + x1 * sn; }
#pragma unroll
    for (int d0 = 0; d0 < 8; ++d0) { const u32x4 w = pack8(xf[d0]); qr[d0] = *reinterpret_cast<const bf16x8*>(&w); }
#pragma unroll
    for (int d0 = 8; d0 < 12; ++d0) *reinterpret_cast<u32x4*>(qx + (d0 - 8) * 1024) = pack8(xf[d0]);
  }
  float m_reg = -1e30f, l_reg = 0; f32x16 o[4] = {};
  const int sr = tid >> 4, sc = (tid & 15) * 8, vst0 = v_st(sr, sc), vst1 = v_st(32 + sr, sc);
  const int kr2 = tid >> 3, kc2 = 128 + (tid & 7) * 8;
  const int vb0 = (int)(uintptr_t)V_lds + v_rd_base(lane);
  const int NT = ntr + 2;
  bf16x8 vs0, vs1, ks0, ks1, ks2;
#define TROW(j) ((j) < ntr ? krow0 + (j) * 64 : mrow0 + ((j) - ntr) * 64)
  const unsigned voV = (unsigned)(sr * LDV + sc) * 2u, voK = (unsigned)(sr * LDK + sc) * 2u, voK2 = (unsigned)(kr2 * LDK + kc2) * 2u;
#define SLOAD(j) do { const long _k0 = TROW(j); const char* _vt = (const char*)Vh + _k0 * (LDV * 2); const char* _kt = (const char*)Kh + _k0 * (LDK * 2); \
    vs0 = *reinterpret_cast<const bf16x8*>(_vt + voV); vs1 = *reinterpret_cast<const bf16x8*>(_vt + 32 * LDV * 2 + voV); \
    ks0 = *reinterpret_cast<const bf16x8*>(_kt + voK); ks1 = *reinterpret_cast<const bf16x8*>(_kt + 32 * LDK * 2 + voK); \
    ks2 = *reinterpret_cast<const bf16x8*>(_kt + voK2); } while (0)
#define SWRITE(b) do { *(bf16x8*)(V_lds + (b) * SHM_V + vst0) = vs0; *(bf16x8*)(V_lds + (b) * SHM_V + vst1) = vs1; const int kc = sc * 2; \
    *(bf16x8*)(K_lds + (b) * SHM_K + KSWZ(sr, kc)) = ks0; *(bf16x8*)(K_lds + (b) * SHM_K + KSWZ(32 + sr, kc)) = ks1; \
    *(bf16x8*)(K_lds + (b) * SHM_K + KSWZ(kr2, kc2 * 2)) = ks2; } while (0)
#define SWAIT() asm volatile("s_waitcnt vmcnt(0)" ::: "memory")
#define RESC(a) do { if (__any((a) < 1.f)) { if (hi == 0) al_l[r32] = (a); asm volatile("s_waitcnt lgkmcnt(0)" ::: "memory"); \
    for (int d = 0; d < 4; ++d) for (int r = 0; r < 16; ++r) o[d][r] *= al_l[crow(r, hi)]; } } while (0)
  f32x16 pA0, pA1, pB0, pB1; float mnA, mnB, alA, alB; bf16x8 pa0, pa1, pa2, pa3;
  SLOAD(0); SWAIT(); SWRITE(0); __syncthreads();
  qkt(pA0, pA1, K_lds, qr, qx, r32, hi, 0); partialSM(pA0, pA1, m_reg, mnA, alA);
  SLOAD(1);
  SWAIT(); SWRITE(1); __syncthreads();
  for (int j = 1; j + 1 < NT; j += 2) {
    SBAR(); qkt(pB0, pB1, K_lds + SHM_K, qr, qx, r32, hi, 0);
    finishSM(pA0, pA1, alA, l_reg, pa0, pa1, pa2, pa3); SBAR();
    SLOAD(j + 1); SBAR();
    pv_d0(o, vb0, pa0, pa1, pa2, pa3); partialSM(pB0, pB1, m_reg, mnB, alB);
    __syncthreads(); SWAIT(); SWRITE(0);
    RESC(alB); __syncthreads();
    SBAR(); qkt(pA0, pA1, K_lds, qr, qx, r32, hi, (j + 1 == ntr) ? 1 : 0);
    finishSM(pB0, pB1, alB, l_reg, pa0, pa1, pa2, pa3); SBAR();
    SLOAD(j + 2); SBAR();
    pv_d0(o, vb0 + SHM_V, pa0, pa1, pa2, pa3); partialSM(pA0, pA1, m_reg, mnA, alA);
    __syncthreads(); SWAIT(); SWRITE(1);
    RESC(alA); __syncthreads();
  }
  SBAR(); qkt(pB0, pB1, K_lds + SHM_K, qr, qx, r32, hi, 2);
  finishSM(pA0, pA1, alA, l_reg, pa0, pa1, pa2, pa3); SBAR();
  pv_d0(o, vb0, pa0, pa1, pa2, pa3); partialSM(pB0, pB1, m_reg, mnB, alB);
  __syncthreads(); RESC(alB);
  finishSM(pB0, pB1, alB, l_reg, pa0, pa1, pa2, pa3); SBAR();
  pv_d0(o, vb0 + SHM_V, pa0, pa1, pa2, pa3);
  if (hi == 0) li_l[r32] = l_reg; asm volatile("s_waitcnt lgkmcnt(0)" ::: "memory");
  float rli[16];
#pragma unroll
  for (int r = 0; r < 16; ++r) rli[r] = __builtin_amdgcn_rcpf(li_l[crow(r, hi)]);
  bf16_t* Ow = Ob + (long)(wid * 32) * LDO;
#pragma unroll
  for (int r = 0; r < 16; ++r) { const int orow = crow(r, hi);
#pragma unroll
    for (int d0 = 0; d0 < 4; ++d0) Ow[(long)orow * LDO + d0 * 32 + r32] = f2bf(o[d0][r] * rli[r]); }
  __syncthreads();
#undef TROW
#undef SLOAD
#undef SWRITE
#undef SWAIT
#undef RESC
}
__device__ __forceinline__ void qkt12(f32x16& p0, f32x16& p1, const char* Ks, const bf16x8* qr, int r32, int hi, int mode) {
  p0 = f32x16{}; p1 = f32x16{};
#pragma unroll
  for (int d0 = 0; d0 < 12; ++d0) { const int cb = (d0 * 16 + hi * 8) * 2;
    bf16x8 b0 = *reinterpret_cast<const bf16x8*>(Ks + KSWZ(r32, cb));
    bf16x8 b1 = *reinterpret_cast<const bf16x8*>(Ks + KSWZ(32 + r32, cb));
    p0 = __builtin_amdgcn_mfma_f32_32x32x16_bf16(b0, qr[d0], p0, 0, 0, 0);
    p1 = __builtin_amdgcn_mfma_f32_32x32x16_bf16(b1, qr[d0], p1, 0, 0, 0); }
  if (mode != 0) {
    constexpr float NEG = -1e30f;
#pragma unroll
    for (int r = 0; r < 16; ++r) p1[r] = NEG;
#pragma unroll
    for (int r = 8; r < 16; ++r) p0[r] = NEG;
    if (mode == 2) {
#pragma unroll
      for (int r = 0; r < 8; ++r) p0[r] = NEG; }
  }
}
constexpr int A2_K = 2 * SHM_V, A2_WS = A2_K + 2 * SHM_K;
__device__ __forceinline__ void attn_body2(const bf16_t* __restrict__ Qb, const bf16_t* __restrict__ Kh, const bf16_t* __restrict__ Vh,
                                           bf16_t* __restrict__ Ob, int krow0, int mrow0, int ntr, char* lds, LAS unsigned char* ldsL, int pos0, const float* __restrict__ qn) {
  int tid_ = threadIdx.x; asm volatile("" : "+v"(tid_));
  const int tid = tid_, wid = __builtin_amdgcn_readfirstlane(tid >> 6), lane = tid & 63, r32 = lane & 31, hi = lane >> 5;
  char* V_lds = lds; char* K_lds = lds + A2_K;
  float* wsf = (float*)(lds + A2_WS) + wid * 64; float* li_l = wsf; float* al_l = wsf + 32;
  bf16x8 qr[8];
  char* qx = lds + A2_WS + 2048 + wid * 4096 + lane * 16;
  { float csv[16], snv[16];
    { const float posf = (float)(pos0 + wid * 32 + r32);
#pragma unroll
      for (int k = 0; k < 16; ++k) { const int i = 16 * (k >> 3) + 8 * hi + (k & 7);
        const float inv = __expf(-(float)(2 * i) * (1.f / 64.f) * 9.210340371976184f);
        sincosf(posf * inv, &snv[k], &csv[k]); asm volatile("" : "+v"(snv[k]), "+v"(csv[k])); } }
    const bf16_t* Qw = Qb + (long)(wid * 32 + r32) * LDQ + hi * 8;
    float xf[12][8]; float ss = 0.f;
#pragma unroll
    for (int d0 = 0; d0 < 12; ++d0) { unpack8(*reinterpret_cast<const u32x4*>(Qw + d0 * 16), xf[d0]);
#pragma unroll
      for (int e = 0; e < 8; ++e) ss += xf[d0][e] * xf[d0][e]; }
    ss += __shfl_xor(ss, 32);
    const float rs = rsqrtf(ss * (1.f / 192.f) + EPS);
#pragma unroll
    for (int d0 = 0; d0 < 12; ++d0) { const f32x4 g0 = *(const f32x4*)(qn + d0 * 16 + hi * 8), g1 = *(const f32x4*)(qn + d0 * 16 + hi * 8 + 4);
#pragma unroll
      for (int e = 0; e < 4; ++e) { xf[d0][e] *= rs * g0[e]; xf[d0][4 + e] *= rs * g1[e]; } }
#pragma unroll
    for (int dd = 0; dd < 2; ++dd)
#pragma unroll
      for (int e = 0; e < 8; ++e) { const float sn = snv[8 * dd + e], cs = csv[8 * dd + e];
        const float x1 = xf[8 + dd][e], x2 = xf[10 + dd][e];
        xf[8 + dd][e] = x1 * cs - x2 * sn; xf[10 + dd][e] = x2 * cs + x1 * sn; }
#pragma unroll
    for (int d0 = 0; d0 < 8; ++d0) { const u32x4 w = pack8(xf[d0]); qr[d0] = *reinterpret_cast<const bf16x8*>(&w); }
#pragma unroll
    for (int d0 = 8; d0 < 12; ++d0) *reinterpret_cast<u32x4*>(qx + (d0 - 8) * 1024) = pack8(xf[d0]);
  }
  float m_reg = -1e30f, l_reg = 0; f32x16 o[4] = {};
  unsigned okk[3], ovv[2];
#pragma unroll
  for (int i = 0; i < 3; ++i) { const int sl = (wid * 3 + i) * 64 + lane, row = sl / 24, cp = sl - row * 24, ch = cp ^ (row & 7); okk[i] = (unsigned)(row * (LDK * 2) + ch * 16); }
#pragma unroll
  for (int i = 0; i < 2; ++i) { const int sl = (wid * 2 + i) * 64 + lane, sub = sl >> 5, kk = (sub >> 2) * 8 + ((sl & 31) >> 2), c = (sub & 3) * 32 + (sl & 3) * 8;
    const int k = (kk & ~0xC) | ((kk & 4) << 1) | ((kk & 8) >> 1); ovv[i] = (unsigned)(k * (LDV * 2) + c * 2); }
  const int vb0 = (int)(uintptr_t)V_lds + v_rd_base(lane);
  const int NT = ntr + 2;
#define TROW(j) ((j) < ntr ? krow0 + (j) * 64 : mrow0 + ((j) - ntr) * 64)
#define ISSUE_K(j, stg) do { const long _k0 = TROW(j); const char* _kt = (const char*)Kh + _k0 * (LDK * 2); _Pragma("unroll") for (int _i = 0; _i < 3; ++_i) \
    __builtin_amdgcn_global_load_lds((const unsigned*)(_kt + okk[_i]), (LAS unsigned*)(ldsL + A2_K + (stg) * SHM_K + (wid * 3 + _i) * 1024), 16, 0, 0); } while (0)
#define ISSUE_V(j, stg) do { const long _k0 = TROW(j); const char* _vt = (const char*)Vh + _k0 * (LDV * 2); _Pragma("unroll") for (int _i = 0; _i < 2; ++_i) \
    __builtin_amdgcn_global_load_lds((const unsigned*)(_vt + ovv[_i]), (LAS unsigned*)(ldsL + (stg) * SHM_V + (wid * 2 + _i) * 1024), 16, 0, 0); } while (0)
#define WAITV(n) asm volatile("s_waitcnt vmcnt(" #n ")" ::: "memory")
#define ABAR() do { asm volatile("s_waitcnt lgkmcnt(0)" ::: "memory"); __builtin_amdgcn_s_barrier(); asm volatile("" ::: "memory"); } while (0)
#define RESC(a) do { if (__any((a) < 1.f)) { if (hi == 0) al_l[r32] = (a); asm volatile("s_waitcnt lgkmcnt(0)" ::: "memory"); \
    for (int d = 0; d < 4; ++d) for (int r = 0; r < 16; ++r) o[d][r] *= al_l[crow(r, hi)]; } } while (0)
  f32x16 pA0, pA1, pB0, pB1; float mnA, mnB, alA, alB; bf16x8 pa0, pa1, pa2, pa3;
  ISSUE_K(0, 0);
  WAITV(0); ABAR();
  ISSUE_K(1, 1); ISSUE_V(0, 0);
  qkt(pA0, pA1, K_lds, qr, qx, r32, hi, 0); partialSM(pA0, pA1, m_reg, mnA, alA);
  WAITV(0); ABAR();
  for (int j = 1; j + 1 < NT; j += 2) {
    ISSUE_K(j + 1, 0); ISSUE_V(j, 1);
    SBAR(); qkt(pB0, pB1, K_lds + SHM_K, qr, qx, r32, hi, 0);
    finishSM(pA0, pA1, alA, l_reg, pa0, pa1, pa2, pa3); SBAR();
    pv_d0(o, vb0, pa0, pa1, pa2, pa3); partialSM(pB0, pB1, m_reg, mnB, alB);
    RESC(alB); WAITV(0); ABAR();
    ISSUE_K(j + 2, 1); ISSUE_V(j + 1, 0);
    SBAR(); qkt(pA0, pA1, K_lds, qr, qx, r32, hi, (j + 1 == ntr) ? 1 : 0);
    finishSM(pB0, pB1, alB, l_reg, pa0, pa1, pa2, pa3); SBAR();
    pv_d0(o, vb0 + SHM_V, pa0, pa1, pa2, pa3); partialSM(pA0, pA1, m_reg, mnA, alA);
    RESC(alA); WAITV(0); ABAR();
  }
  ISSUE_V(NT - 1, 1);
  SBAR(); qkt(pB0, pB1, K_lds + SHM_K, qr, qx, r32, hi, 2);
  finishSM(pA0, pA1, alA, l_reg, pa0, pa1, pa2, pa3); SBAR();
  pv_d0(o, vb0, pa0, pa1, pa2, pa3); partialSM(pB0, pB1, m_reg, mnB, alB);
  WAITV(0); ABAR(); RESC(alB);
  finishSM(pB0, pB1, alB, l_reg, pa0, pa1, pa2, pa3); SBAR();
  pv_d0(o, vb0 + SHM_V, pa0, pa1, pa2, pa3);
  if (hi == 0) li_l[r32] = l_reg; asm volatile("s_waitcnt lgkmcnt(0)" ::: "memory");
  float rli[16];
#pragma unroll
  for (int r = 0; r < 16; ++r) rli[r] = __builtin_amdgcn_rcpf(li_l[crow(r, hi)]);
  bf16_t* Ow = Ob + (long)(wid * 32) * LDO;
#pragma unroll
  for (int r = 0; r < 16; ++r) { const int orow = crow(r, hi);
#pragma unroll
    for (int d0 = 0; d0 < 4; ++d0) Ow[(long)orow * LDO + d0 * 32 + r32] = f2bf(o[d0][r] * rli[r]); }
  ABAR();
#undef TROW
#undef ISSUE_K
#undef ISSUE_V
#undef WAITV
#undef ABAR
#undef RESC
}
__device__ void phase_attn(const Params& p0, const Grp& G, char* lds, LAS unsigned char* ldsL) { Params p = p0; p.ws = opaque(p0.ws);
  const bf16_t* Q = (const bf16_t*)G.out;
  const bf16_t* Kb = (const bf16_t*)(p.ws + O_QK) + (size_t)RGMAX * 1536; const bf16_t* Vb = (const bf16_t*)(p.ws + O_V);
  const float* qn = (const float*)(p.ws + O_SMALL) + S_QN;
  bf16_t* O = (bf16_t*)(p.ws + O_OMLA);
  const int nqb = G.Ls / 256;
  const int nitems = G.nseq * 8 * nqb;
  for (int it = BIDX(); it < nitems; it += gridDim.x) {
    const int h = it & 7, rest = it >> 3, s = rest / nqb, qb = rest % nqb;
    const int qrow = s * G.Ls + qb * 256;
#ifdef ATTN_REGSTAGE
    attn_body(Q + (size_t)qrow * LDQ + h * 192, Kb + h * 192, Vb + h * 128, O + (size_t)qrow * LDO + h * 128, s * G.Ls, NREAL + 256 * s, G.Ls / 64, lds, 16 + qb * 256, qn);
#else
    attn_body2(Q + (size_t)qrow * LDQ + h * 192, Kb + h * 192, Vb + h * 128, O + (size_t)qrow * LDO + h * 128, s * G.Ls, NREAL + 256 * s, G.Ls / 64, lds, ldsL, 16 + qb * 256, qn);
#endif
  }
}

constexpr int LGP = 129;
__device__ __forceinline__ float logsigmoidf_(float x) { return fminf(x, 0.f) - log1pf(__expf(-fabsf(x))); }
LPHASE void phase_gla_prep(char* ws_, const float* x_, float* out_, const float* meta_, int nseq_, char* lds) {
  const int tid0 = TIDX();
  char* wsp = opaque(ws_);
  const bf16_t* b2 = (const bf16_t*)(wsp + O_B2); const bf16_t* b4 = (const bf16_t*)(wsp + O_B4);
  char* gp = wsp + O_GP;
  float* lgF = (float*)lds; float* lgB = lgF + 64 * LGP;
  char* R2 = lds + 2 * 64 * LGP * 4;
  bf16_t* qhF = (bf16_t*)R2; bf16_t* khF = qhF + 64 * 128; bf16_t* qhB = khF + 64 * 128; bf16_t* khB = qhB + 64 * 128;
  float* af = (float*)R2;
  bf16_t* vt = (bf16_t*)(R2 + 8192);
  float* tot = (float*)(R2 + 65536);
  const float* smg = (const float*)(wsp + O_SMALL);
  const int nmeta = 4 * nseq_, bid = BIDX();
  for (int kk = (bid < nmeta ? -1 : 0); ; ++kk) {
    const int it = kk < 0 ? 1024 + bid : bid + kk * (int)gridDim.x;
    if (kk >= 0 && it >= 1024) break;
    int tid_ = tid0; asm volatile("" : "+v"(tid_));
    const int tid = tid_, wid = tid >> 6, lane = tid & 63, d = tid & 127, ig = tid >> 7;
    const int ch = it >> 2, hd = it & 3;
    const bool ismeta = ch >= 256;
    const int row0 = ismeta ? NREAL + 256 * (ch - 256) : ch * 64;
    unsigned qk[16];
    { const unsigned voff = (unsigned)(ig * 16 * 2048 + d) * 2u;
      const char* ub = (const char*)(b2 + (size_t)row0 * 2048 + hd * 128);
#pragma unroll
      for (int ii = 0; ii < 16; ++ii) { const char* ubi = ub + ii * 4096;
        qk[ii] = (unsigned)*(const bf16_t*)(ubi + voff) | ((unsigned)*(const bf16_t*)(ubi + 1024 + voff) << 16); } }
    {
#pragma unroll
      for (int q = 0; q < 4; ++q) { const int c = tid + q * NTHR, i = c >> 5, c8 = (c & 31) * 8;
        *(u32x4*)(vt + i * 264 + c8) = *(const u32x4*)(b2 + (size_t)(row0 + i) * 2048 + 1024 + hd * 256 + c8); }
      for (int e = tid; e < 64 * 32; e += NTHR) { const int i = e >> 5, c = e & 31; af[e] = bf2f(b4[(size_t)(row0 + i) * 256 + 64 + c]); }
    }
    __syncthreads();
    { bf16_t* dst = (bf16_t*)(gp + GP_VT) + ((size_t)ch * 4 + hd) * 256 * 64;
#pragma unroll
      for (int q = 0; q < 4; ++q) { const int i8 = (tid & 7) * 8, c = (tid >> 3) + 64 * q; bf16x8 w;
#pragma unroll
        for (int e = 0; e < 8; ++e) w[e] = (short)vt[(i8 + e) * 264 + c];
        *(bf16x8*)(dst + c * 64 + i8) = w; } }
    { float wf[16], wb[16];
#pragma unroll
      for (int k = 0; k < 16; ++k) { wf[k] = smg[S_WAF + k * 512 + hd * 128 + d]; wb[k] = smg[S_WAB + k * 512 + hd * 128 + d]; }
      const float bfv = smg[S_BAF + hd * 128 + d], bbv = smg[S_BAB + hd * 128 + d];
      float tfl = 0.f, tbl = 0.f;
#pragma unroll 2
      for (int ii = 0; ii < 16; ++ii) { const int i = ig * 16 + ii; float sf = bfv, sb = bbv; const float* a = af + i * 32;
#pragma unroll
        for (int k = 0; k < 16; ++k) { sf += a[k] * wf[k]; sb += a[16 + k] * wb[k]; }
        float lf = (fminf(sf, 0.f) - __logf(1.f + __expf(-fabsf(sf)))) * (1.f / 16.f), lb = (fminf(sb, 0.f) - __logf(1.f + __expf(-fabsf(sb)))) * (1.f / 16.f);
        if (ismeta && i >= 16) { lf = 0.f; lb = 0.f; }
        lgF[i * LGP + d] = lf; lgB[i * LGP + d] = lb; tfl += lf; tbl += lb; }
      tot[ig * 128 + d] = tfl; tot[512 + ig * 128 + d] = tbl;
    }
    __syncthreads();
    { const float t0 = tot[d], t1 = tot[128 + d], t2 = tot[256 + d], t3 = tot[384 + d];
      const float u0 = tot[512 + d], u1 = tot[640 + d], u2 = tot[768 + d], u3 = tot[896 + d];
      const float blF = (t0 + t1) + (t2 + t3), brF = t0 + t1, blB = (u0 + u1) + (u2 + u3), brB = u2 + u3;
      const float offF = ig == 0 ? 0.f : ig == 1 ? t0 : ig == 2 ? t0 + t1 : (t0 + t1) + t2;
      const float offB = ig == 3 ? 0.f : ig == 2 ? u3 : ig == 1 ? u2 + u3 : (u1 + u2) + u3;
      const float myB = ig == 0 ? u0 : ig == 1 ? u1 : ig == 2 ? u2 : u3;
      if (ig == 0) { float* dc = (float*)(gp + GP_DC) + ((size_t)ch * 4 + hd) * 2 * 128; dc[d] = __expf(blF); dc[128 + d] = __expf(blB); }
      bf16_t* qtF = (bf16_t*)(gp + GP_QT) + (((size_t)ch * 4 + hd) * 2 + 0) * 64 * 128; bf16_t* qtB = qtF + 64 * 128;
      float runF = offF, runB = offB + myB;
#pragma unroll
      for (int ii = 0; ii < 16; ++ii) { const int i = ig * 16 + ii;
        const float q = bflo(qk[ii]) * 0.08838834764831845f, k = bfhi(qk[ii]);
        const float lf = lgF[i * LGP + d], lb = lgB[i * LGP + d];
        runF += lf; const float bcF = runF, bcB = runB; runB -= lb;
        qtF[i * 128 + d] = f2bf(q * __expf(bcF)); qtB[i * 128 + d] = f2bf(q * __expf(bcB));
        qhF[i * 128 + d] = f2bf(q * __expf(bcF - brF)); khF[i * 128 + d] = f2bf(k * __expf(brF - bcF));
        qhB[i * 128 + d] = f2bf(q * __expf(bcB - brB)); khB[i * 128 + d] = f2bf(k * __expf(brB - bcB));
        lgF[i * LGP + d] = k * __expf(blF - bcF); lgB[i * LGP + d] = k * __expf(blB - bcB);
        if ((ii & 1) == 1) asm volatile("" ::: "memory"); }
    }
    __syncthreads();
    { bf16_t* ktF = (bf16_t*)(gp + GP_KT) + (((size_t)ch * 4 + hd) * 2 + 0) * 128 * 64; bf16_t* ktB = ktF + 128 * 64;
#pragma unroll
      for (int q = 0; q < 2; ++q) { const int i8 = (tid & 7) * 8, dd = (tid >> 3) + 64 * q; float f[8];
#pragma unroll
        for (int e = 0; e < 8; ++e) f[e] = lgF[(i8 + e) * LGP + dd];
        *(u32x4*)(ktF + dd * 64 + i8) = pack8(f);
#pragma unroll
        for (int e = 0; e < 8; ++e) f[e] = lgB[(i8 + e) * LGP + dd];
        *(u32x4*)(ktB + dd * 64 + i8) = pack8(f); }
      const int dir = wid >> 2, qi = (wid >> 1) & 1, qj = wid & 1, r32 = lane & 31, hi = lane >> 5;
      const bf16_t* qh = dir ? qhB : qhF; const bf16_t* kh = dir ? khB : khF;
      f32x16 acc = {};
#pragma unroll
      for (int ks = 0; ks < 8; ++ks) {
        const bf16x8 a = *(const bf16x8*)(qh + (32 * qi + r32) * 128 + ks * 16 + hi * 8);
        const bf16x8 b = *(const bf16x8*)(kh + (32 * qj + r32) * 128 + ks * 16 + hi * 8);
        acc = __builtin_amdgcn_mfma_f32_32x32x16_bf16(a, b, acc, 0, 0, 0); }
      bf16_t* am = (bf16_t*)(gp + GP_AM) + (((size_t)ch * 4 + hd) * 2 + dir) * 64 * 64;
#pragma unroll
      for (int r = 0; r < 16; ++r) { const int i = 32 * qi + crow(r, hi), j = 32 * qj + r32;
        const bool keep = dir ? (i <= j) : (i >= j);
        am[i * 64 + j] = f2bf(keep ? acc[r] : 0.f); }
    }
    __syncthreads();
  }
}

constexpr int GS_QT = 0, GS_KT = 16384, GS_AM = 32768, GS_DC = 40960, GS_STAGE = 41472;
#define GS_WAIT(n) asm volatile("s_waitcnt vmcnt(" #n ")" ::: "memory")
template <bool FINAL>
LPHASE void phase_gla_scan(char* ws_, int nseq_, char* ldsg, LAS unsigned char* lds) {
  const int tid = TIDX(), wid = __builtin_amdgcn_readfirstlane(tid >> 6), lane = tid & 63, fr = lane & 15, fq = lane >> 4;
  char* wsp = opaque(ws_);
  char* gp = wsp + O_GP;
  const int Ls = nseq_ == 2 ? 8192 : 16384;
  const int CS = Ls / 64, nls = CS / 16;
  unsigned oq[2], ok[2], oa;
#pragma unroll
  for (int j = 0; j < 2; ++j) { const int pq = 128 * wid + 64 * j + lane, rq = pq >> 4, cq = (pq & 15) ^ (rq & 15); oq[j] = (unsigned)(rq * 256 + cq * 16);
    const int pk = 128 * wid + 64 * j + lane, rk = pk >> 3, ck = (pk & 7) ^ (rk & 7); ok[j] = (unsigned)(rk * 128 + ck * 16); }
  { const int pa = 64 * wid + lane, ra = pa >> 3, ca = (pa & 7) ^ (ra & 7); oa = (unsigned)(ra * 128 + ca * 16); }
  for (int it = BIDX(); it < 256; it += gridDim.x) {
    const int half = it & 1, dir = (it >> 1) & 1, hd = (it >> 2) & 3, sg = it >> 4;
    const int s = sg / nls, ls = sg % nls;
    const int colb = half * 128 + wid * 16;
    float* Ub = (float*)(gp + GP_U); float* Db = (float*)(gp + GP_D);
    const bool has_meta = (dir == 0 && ls == 0);
    const int nsteps = 16 + (has_meta ? 1 : 0);
    auto chunk_of = [&](int st) -> int {
      if (dir == 0) { if (has_meta) return st == 0 ? 256 + s : s * CS + (st - 1); return s * CS + ls * 16 + st; }
      return s * CS + ls * 16 + (15 - st); };
    bf16x8 v0a, v0b, v1a, v1b, v2a, v2b;
#define GS_ISSUE(st_, sgi_, VA, VB) do { const int _st = (st_) < nsteps ? (st_) : nsteps - 1; const int _ch = chunk_of(_st); const size_t _cb = ((size_t)_ch * 4 + hd) * 2 + dir; \
      const unsigned _lb = (unsigned)(sgi_) * GS_STAGE; \
      const char* _kt = gp + GP_KT + _cb * 16384; \
      __builtin_amdgcn_global_load_lds((const unsigned*)(_kt + ok[0]), (LAS unsigned*)(lds + _lb + GS_KT + (128 * wid) * 16), 16, 0, 0); \
      __builtin_amdgcn_global_load_lds((const unsigned*)(_kt + ok[1]), (LAS unsigned*)(lds + _lb + GS_KT + (128 * wid + 64) * 16), 16, 0, 0); \
      if (FINAL) { const char* _qt = gp + GP_QT + _cb * 16384; const char* _am = gp + GP_AM + _cb * 8192; \
        __builtin_amdgcn_global_load_lds((const unsigned*)(_qt + oq[0]), (LAS unsigned*)(lds + _lb + GS_QT + (128 * wid) * 16), 16, 0, 0); \
        __builtin_amdgcn_global_load_lds((const unsigned*)(_qt + oq[1]), (LAS unsigned*)(lds + _lb + GS_QT + (128 * wid + 64) * 16), 16, 0, 0); \
        __builtin_amdgcn_global_load_lds((const unsigned*)(_am + oa), (LAS unsigned*)(lds + _lb + GS_AM + (64 * wid) * 16), 16, 0, 0); } \
      if (lane < 4) __builtin_amdgcn_global_load_lds((const unsigned*)(gp + GP_DC + _cb * 512 + (4 * wid + lane) * 16), (LAS unsigned*)(lds + _lb + GS_DC + (4 * wid) * 16), 16, 0, 0); \
      const bf16_t* _vt = (const bf16_t*)(gp + GP_VT) + ((size_t)_ch * 4 + hd) * 256 * 64 + (size_t)(colb + fr) * 64; \
      VA = *(const bf16x8*)(_vt + fq * 8); VB = *(const bf16x8*)(_vt + 32 + fq * 8); } while (0)
    GS_ISSUE(0, 0, v0a, v0b);
    GS_ISSUE(1, 1, v1a, v1b);
    f32x4 S[8];
#pragma unroll
    for (int t = 0; t < 8; ++t) S[t] = (f32x4){0.f, 0.f, 0.f, 0.f};
    f32x4 Dc[8];
#pragma unroll
    for (int t = 0; t < 8; ++t) Dc[t] = (f32x4){1.f, 1.f, 1.f, 1.f};
    if (FINAL) {
      const int np = dir ? (nls - 1 - ls) : ls;
      f32x4 W[8];
#pragma unroll
      for (int t = 0; t < 8; ++t) W[t] = (f32x4){1.f, 1.f, 1.f, 1.f};
#pragma unroll 2
      for (int q = 0; q < np; ++q) { const int ps = dir ? (ls + 1 + q) : (ls - 1 - q); const int psg = s * nls + ps;
        const f32x4* U = (const f32x4*)(Ub + (((size_t)psg * 4 + hd) * 2 + dir) * 128 * 256) + ((size_t)(colb >> 4) * 8) * 64 + lane; const float* D = Db + (((size_t)psg * 4 + hd) * 2 + dir) * 128;
#pragma unroll
        for (int t = 0; t < 8; ++t) { const f32x4 dv = *(const f32x4*)(D + 16 * t + 4 * fq); const f32x4 uv = U[t * 64];
          S[t] += W[t] * uv; W[t] *= dv; } }
    }
    for (int st = 0; st < nsteps; ++st) {
      const bool metastep = has_meta && st == 0;
      const bool prev_stores = FINAL && st > 0 && !(has_meta && st == 1);
      if (FINAL) { if (prev_stores) GS_WAIT(24); else GS_WAIT(8); } else GS_WAIT(5);
      asm volatile("s_waitcnt lgkmcnt(0)" ::: "memory"); __builtin_amdgcn_s_barrier(); asm volatile("" ::: "memory");
      const int sgi2 = (st + 2) % 3;
      GS_ISSUE(st + 2, sgi2, v2a, v2b);
      const char* L = ldsg + (st % 3) * GS_STAGE;
      if (FINAL && !metastep) {
        const int ch = chunk_of(st);
        bf16x8 sB[4];
#pragma unroll
        for (int ks = 0; ks < 4; ++ks) { u32x4 w; w.x = cvtpk(S[2 * ks][0], S[2 * ks][1]); w.y = cvtpk(S[2 * ks][2], S[2 * ks][3]);
          w.z = cvtpk(S[2 * ks + 1][0], S[2 * ks + 1][1]); w.w = cvtpk(S[2 * ks + 1][2], S[2 * ks + 1][3]); sB[ks] = *reinterpret_cast<bf16x8*>(&w); }
        bf16_t* od = (bf16_t*)(wsp + O_OFB) + (size_t)dir * NREAL * 1024 + (size_t)(ch * 64) * 1024 + hd * 256 + colb + fr;
#pragma unroll
        for (int mt = 0; mt < 4; ++mt) {
          f32x4 o = (f32x4){0.f, 0.f, 0.f, 0.f};
          const char* ar = L + GS_AM + (16 * mt + fr) * 128;
          o = __builtin_amdgcn_mfma_f32_16x16x32_bf16(*(const bf16x8*)(ar + (((fq) ^ (fr & 7)) << 4)), v0a, o, 0, 0, 0);
          o = __builtin_amdgcn_mfma_f32_16x16x32_bf16(*(const bf16x8*)(ar + (((4 + fq) ^ (fr & 7)) << 4)), v0b, o, 0, 0, 0);
          const char* qrw = L + GS_QT + (16 * mt + fr) * 256 + (fq & 1) * 8;
#pragma unroll
          for (int ks = 0; ks < 4; ++ks) { const s16x4 lo = *(const s16x4*)(qrw + (((4 * ks + (fq >> 1)) ^ fr) << 4)), hi4 = *(const s16x4*)(qrw + (((4 * ks + 2 + (fq >> 1)) ^ fr) << 4));
            const bf16x8 a = (bf16x8){lo[0], lo[1], lo[2], lo[3], hi4[0], hi4[1], hi4[2], hi4[3]};
            o = __builtin_amdgcn_mfma_f32_16x16x32_bf16(a, sB[ks], o, 0, 0, 0); }
#pragma unroll
          for (int j = 0; j < 4; ++j) od[(size_t)(16 * mt + 4 * fq + j) * 1024] = f2bf(o[j]);
        }
      }
#pragma unroll
      for (int t = 0; t < 8; ++t) { const f32x4 dv = *(const f32x4*)(L + GS_DC + (16 * t + 4 * fq) * 4);
        S[t] *= dv; if (!FINAL) Dc[t] *= dv;
        const char* kr = L + GS_KT + (16 * t + fr) * 128;
        S[t] = __builtin_amdgcn_mfma_f32_16x16x32_bf16(*(const bf16x8*)(kr + (((fq) ^ (fr & 7)) << 4)), v0a, S[t], 0, 0, 0);
        S[t] = __builtin_amdgcn_mfma_f32_16x16x32_bf16(*(const bf16x8*)(kr + (((4 + fq) ^ (fr & 7)) << 4)), v0b, S[t], 0, 0, 0); }
      v0a = v1a; v0b = v1b; v1a = v2a; v1b = v2b;
    }
    GS_WAIT(0); __syncthreads();
    if (!FINAL) {
      float* U = Ub + (((size_t)sg * 4 + hd) * 2 + dir) * 128 * 256; float* D = Db + (((size_t)sg * 4 + hd) * 2 + dir) * 128;
#pragma unroll
      for (int t = 0; t < 8; ++t) {
        ((f32x4*)U)[((size_t)(colb >> 4) * 8 + t) * 64 + lane] = S[t];
        if (half == 0 && wid == 0 && fr == 0) *(f32x4*)(D + 16 * t + 4 * fq) = Dc[t]; }
    }
#undef GS_ISSUE
  }
}

#ifndef NO_GEMM
#define GEMMCALL(l,g,e) gemm_phase(l,g,e)
#else
#define GEMMCALL(l,g,e) (void)0
#endif
#define LA p.ws, G.x, G.out, p.meta, G.nseq

#define XB_TMO      128
#define XB_XCNT(j)  (256  + 64 * (j))
#define XB_XSUB(j)  (1280 + 64 * (j))
#define XB_XGEN(j)  (2304 + 64 * (j))
#define XB_TOP      3328
#define XB_TOPGEN   3392
#define XCD_BAR_WORDS 3456
#define XB_SPIN_CAP (1u << 22)
__device__ __forceinline__ unsigned xb_ld(unsigned* p)              { return __hip_atomic_load(p, __ATOMIC_RELAXED, __HIP_MEMORY_SCOPE_AGENT); }
__device__ __forceinline__ unsigned xb_add(unsigned* p, unsigned v) { return __hip_atomic_fetch_add(p, v, __ATOMIC_RELAXED, __HIP_MEMORY_SCOPE_AGENT); }
__device__ __forceinline__ unsigned xb_xcc_id() { return (unsigned)__builtin_amdgcn_s_getreg((3 << 11) | 20) & 0xFu; }
#define XB_SPIN(cond, bar) do { unsigned _sp = 0; while (cond) { __builtin_amdgcn_s_sleep(1); \
    if ((++_sp & 255u) == 0u) { if (xb_ld(&(bar)[XB_TMO])) break; if (_sp > XB_SPIN_CAP) { atomicAdd(&(bar)[XB_TMO], 1u); break; } } } } while (0)
struct XcdBarrier { unsigned* bar; unsigned x; volatile LAS unsigned* st; };
__device__ __forceinline__ XcdBarrier xcd_barrier_post(unsigned* bar, volatile LAS unsigned* st) {
  XcdBarrier b; b.bar = bar; b.x = xb_xcc_id(); b.st = st;
  if (threadIdx.x == 0) (void)xb_add(&bar[XB_XCNT(b.x)], 1u);
  return b;
}
__device__ __forceinline__ void xcd_barrier_complete(unsigned* bar, unsigned x, unsigned& nloc, unsigned& nx) {
  const unsigned G = gridDim.x * gridDim.y * gridDim.z;
  unsigned sum, cnt, mine, sp = 0u;
  for (;;) {
    sum = 0u; cnt = 0u; mine = 0u;
#pragma unroll
    for (unsigned j = 0; j < 16; ++j) { const unsigned c = xb_ld(&bar[XB_XCNT(j)]); sum += c; cnt += (c > 0u) ? 1u : 0u; mine = (j == x) ? c : mine; }
    if (sum == G) break;
    __builtin_amdgcn_s_sleep(1);
    if ((++sp & 255u) == 0u) { if (xb_ld(&bar[XB_TMO])) break; if (sp > XB_SPIN_CAP) { atomicAdd(&bar[XB_TMO], 1u); break; } }
  }
  nloc = mine > 0u ? mine : 1u; nx = cnt > 0u ? cnt : 1u;
}
__device__ __forceinline__ void xcd_barrier(const XcdBarrier& b) {
  asm volatile("s_waitcnt vmcnt(0)" ::: "memory");
  __syncthreads();
  if (threadIdx.x == 0) {
    unsigned* bar = b.bar;
    __builtin_amdgcn_s_waitcnt(0);
    unsigned nloc = b.st[0], nx = b.st[1];
    if (nloc == 0u) { xcd_barrier_complete(bar, b.x, nloc, nx); b.st[0] = nloc; b.st[1] = nx; }
    const unsigned old = xb_add(&bar[XB_XSUB(b.x)], 1u);
    const unsigned gen = old / nloc;
    if (old + 1u == (gen + 1u) * nloc) {
      __builtin_amdgcn_fence(__ATOMIC_RELEASE, "agent");
      asm volatile("s_waitcnt vmcnt(0)" ::: "memory");
      const unsigned og = xb_add(&bar[XB_TOP], 1u);
      const unsigned tg = og / nx;
      if (og + 1u == (tg + 1u) * nx) xb_add(&bar[XB_TOPGEN], 1u);
      else XB_SPIN(xb_ld(&bar[XB_TOPGEN]) == tg, bar);
      __builtin_amdgcn_fence(__ATOMIC_ACQUIRE, "agent");
      xb_add(&bar[XB_XGEN(b.x)], 1u);
      asm volatile("s_waitcnt vmcnt(0)" ::: "memory");
    } else {
      XB_SPIN(xb_ld(&bar[XB_XGEN(b.x)]) == gen, bar);
      __builtin_amdgcn_fence(__ATOMIC_ACQUIRE, "agent");
      asm volatile("s_waitcnt vmcnt(0)" ::: "memory");
    }
  }
  __syncthreads();
}
struct EpiGen { int kind, kind2; bf16_t *b0, *b1, *b2, *b3; float* f0; const float* cf0;
  __device__ __forceinline__ void st2(int w, int r, int c, f32x4 v0, f32x4 v1) const {
    switch (w ? kind2 : kind) {
      case 0: { EpiInproj E{b0, b1, b2, b3}; E.st(r, c, v0, v1); } break;
      case 1: { EpiBf16 E{b0, 1536}; E.st(r, c, v0, v1); } break;
      case 2: { EpiKV E{b0, b1}; E.st(r, c, v0, v1); } break;
      case 3: { EpiGateA E{b0, b2}; E.st(r, c, v0, v1); } break;
      case 4: { EpiGateB E{b0, b2, b1}; E.st(r, c, v0, v1); } break;
      case 5: { EpiX1 E{cf0, f0}; E.st(r, c, v0, v1); } break;
      case 6: { EpiFfnUp E{b0}; E.st(r, c, v0, v1); } break;
      default: { EpiFfnDown E{f0}; E.st(r, c, v0, v1); } break;
    }
  } };

constexpr int NSTEP_G = 17;
__global__ void __launch_bounds__(NTHR, 2) mega(Params p) {
  extern __shared__ __attribute__((aligned(16))) unsigned char lds_raw[];
  cg::grid_group grid = cg::this_grid();
  LAS unsigned char* lds = (LAS unsigned char*)lds_raw;
  char* ldsg = (char*)lds_raw;
  if (threadIdx.x < 4) ((LAS unsigned*)(lds + LDS_BYTES - 16))[threadIdx.x] = 0u;
  __syncthreads();
  const XcdBarrier xb = xcd_barrier_post((unsigned*)(p.ws + O_BAR), (volatile LAS unsigned*)(lds + LDS_BYTES - 16));
  phase_weights(p);
  grid.sync();
#ifdef PROBE_AT
  constexpr int NSTP = NSTEP_G + 1;
#else
  constexpr int NSTP = NSTEP_G;
#endif
#pragma unroll 1
  for (int step = 0; step < 3 * NSTP; ++step) {
    const int g = step / NSTP; int ph = step % NSTP;
#ifdef PROBE_AT
    ph -= (ph > PROBE_AT) ? 1 : 0;
#endif
    char* ws = opaque(p.ws);
    const Grp G = make_grp(p, g);
    bool is_gemm = false, sync_after = true;
    Gemm gm{nullptr, nullptr, 1024, 1024, NREAL, 1024, 1024, nullptr, nullptr};
    EpiGen E{0, 0, nullptr, nullptr, nullptr, nullptr, nullptr, nullptr};
    switch (ph) {
      case 0: rows_h(LA); break;
      case 1: is_gemm = true; gm = Gemm{(const bf16_t*)(ws + O_H), (const bf16_t*)(ws + O_WIN), 1024, 1024, G.RG, NIN, 1024, nullptr, nullptr};
              E.kind = 0; E.b0 = (bf16_t*)(ws + O_B1); E.b1 = (bf16_t*)(ws + O_B2); E.b2 = (bf16_t*)(ws + O_G3); E.b3 = (bf16_t*)(ws + O_B4); break;
      case 2: rows_cnorm(LA); sync_after = false; break;
#ifndef NO_PREP
      case 3: phase_gla_prep(p.ws, G.x, G.out, p.meta, G.nseq, ldsg); break;
#endif
      case 4: is_gemm = true; sync_after = false; gm = Gemm{(const bf16_t*)(ws + O_B1), (const bf16_t*)(ws + O_WUQ), 1024, 768, G.RG, 1536, 768, nullptr, nullptr};
              E.kind = 1; E.b0 = (bf16_t*)G.out; break;
      case 5: is_gemm = true; sync_after = false; gm = Gemm{(const bf16_t*)(ws + O_B1) + 768, (const bf16_t*)(ws + O_WUKV), 1024, 256, G.RG, 2048, 256, nullptr, nullptr};
              E.kind = 2; E.b0 = (bf16_t*)(ws + O_KNR); E.b1 = (bf16_t*)(ws + O_V); break;
#ifndef NO_SCAN
      case 6: phase_gla_scan<false>(p.ws, G.nseq, ldsg, lds); break;
#endif
      case 7: rows_qk(LA); sync_after = false; break;
#ifndef NO_SCAN2
      case 8: phase_gla_scan<true>(p.ws, G.nseq, ldsg, lds); break;
#endif
      case 9: rows_ogla(LA); sync_after = false; break;
      case 10: phase_attn(p, G, ldsg, lds); break;
      case 11: is_gemm = true; gm = Gemm{(const bf16_t*)(ws + O_OMLA), (const bf16_t*)(ws + O_WOM), 1024, 1024, NREAL, 1024, 1024, (const bf16_t*)(ws + O_OGLA), (const bf16_t*)(ws + O_WOG)};
              E.kind = 3; E.kind2 = 4; E.b0 = (bf16_t*)(ws + O_G3); E.b2 = (bf16_t*)(ws + O_TMP); E.b1 = (bf16_t*)(ws + O_MIX); break;
      case 12: sync_after = false; break;
      case 13: is_gemm = true; gm = Gemm{(const bf16_t*)(ws + O_MIX), (const bf16_t*)(ws + O_WOUT), 1024, 1024, NREAL, 1024, 1024, nullptr, nullptr};
              E.kind = 5; E.cf0 = G.x; E.f0 = G.out; break;
      case 14: rows_h2(LA); break;
      case 15: is_gemm = true; gm = Gemm{(const bf16_t*)(ws + O_H2), (const bf16_t*)(ws + O_WGU), 1024, 1024, NREAL, 5632, 1024, nullptr, nullptr};
              E.kind = 6; E.b0 = (bf16_t*)(ws + O_ACT); break;
      default: is_gemm = true; gm = Gemm{(const bf16_t*)(ws + O_ACT), (const bf16_t*)(ws + O_WD), DFF, DFF, NREAL, 1024, DFF, nullptr, nullptr};
              E.kind = 7; E.f0 = G.out; break;
    }
    if (is_gemm) gemm_phase(lds, gm, E);
    if (sync_after) xcd_barrier(xb);
  }
}

extern "C" void kernel_launch(void* const* d_in, const int* in_sizes, int n_in, void* d_out, int out_size, void* d_ws, size_t ws_size, hipStream_t stream) {
  static int grid_blocks = 0;
  if (grid_blocks == 0) {
    if (n_in != 23 || ws_size < WS_END) { fprintf(stderr, "kernel_launch: unexpected inputs (n_in %d, ws %zu, need %zu)\n", n_in, ws_size, (size_t)WS_END); grid_blocks = -1; return; }
    int dev = 0, cus = 0, per_cu = 0;
    (void)hipGetDevice(&dev); (void)hipDeviceGetAttribute(&cus, hipDeviceAttributeMultiprocessorCount, dev);
    if (hipFuncSetAttribute((const void*)mega, hipFuncAttributeMaxDynamicSharedMemorySize, LDS_BYTES) != hipSuccess) { fprintf(stderr, "kernel_launch: hipFuncSetAttribute failed\n"); grid_blocks = -1; return; }
    if (hipOccupancyMaxActiveBlocksPerMultiprocessor(&per_cu, (const void*)mega, NTHR, LDS_BYTES) != hipSuccess || per_cu < 1) { fprintf(stderr, "kernel_launch: occupancy query gives %d\n", per_cu); per_cu = 1; }
    (void)hipGetLastError();
    grid_blocks = cus * per_cu;
    if (grid_blocks > 256) grid_blocks = 256;
  }
  if (grid_blocks < 0) return;
  Params p{};
  const float** pp = (const float**)&p;
  for (int i = 0; i < 23; ++i) pp[i] = (const float*)d_in[i];
  p.out = (float*)d_out; p.ws = (char*)d_ws;
  (void)hipMemsetAsync((char*)d_ws + O_BAR, 0, 3456 * 4, stream);
  void* args[] = {&p};
  hipError_t e = hipLaunchCooperativeKernel((const void*)mega, dim3(grid_blocks), dim3(NTHR), args, LDS_BYTES, stream);
  if (e != hipSuccess) fprintf(stderr, "cooperative launch failed: %s (grid %d)\n", hipGetErrorString(e), grid_blocks);
}
```

```cpp
#include <hip/hip_runtime.h>
#include <hip/hip_cooperative_groups.h>
#include <cstdio>
#include <cstdint>
namespace cg = cooperative_groups;

typedef unsigned short bf16_t;
typedef short bf16x8 __attribute__((ext_vector_type(8)));
typedef short s16x4 __attribute__((ext_vector_type(4)));
typedef float f32x4 __attribute__((ext_vector_type(4)));
typedef float f32x16 __attribute__((ext_vector_type(16)));
typedef unsigned u32x4 __attribute__((ext_vector_type(4)));
typedef unsigned u32x2 __attribute__((ext_vector_type(2)));
#define LAS __attribute__((address_space(3)))
#define SBAR() __builtin_amdgcn_sched_barrier(0)
__device__ __forceinline__ int TIDX() { int t = threadIdx.x; asm volatile("" : "+v"(t)); return t; }
__device__ __forceinline__ char* opaque(char* q) { size_t z = 0; asm volatile("" : "+s"(z)); return q + z; }
__device__ __forceinline__ int BIDX() { int b = blockIdx.x; asm volatile("" : "+s"(b)); return b; }

constexpr int DM = 1024, NREAL = 16384, RGMAX = NREAL + 512, DIN = 6240, NIN = 6400, DFF = 2816;
constexpr float EPS = 1e-6f;
constexpr int NTHR = 512;
constexpr int LDS_BYTES = 136 * 1024;

constexpr size_t al256(size_t x) { return (x + 255) / 256 * 256; }
constexpr size_t O_WIN = 0;
constexpr size_t O_WUQ = O_WIN + (size_t)NIN * 1024 * 2;
constexpr size_t O_WUKV = O_WUQ + (size_t)1536 * 768 * 2;
constexpr size_t O_WOM = O_WUKV + (size_t)2048 * 256 * 2;
constexpr size_t O_WOG = O_WOM + (size_t)1024 * 1024 * 2;
constexpr size_t O_WOUT = O_WOG + (size_t)1024 * 1024 * 2;
constexpr size_t O_WGU = O_WOUT + (size_t)1024 * 1024 * 2;
constexpr size_t O_WD = O_WGU + (size_t)5632 * 1024 * 2;
constexpr size_t O_G3 = O_WD + (size_t)1024 * DFF * 2;
constexpr size_t O_GP = O_G3 + (size_t)NREAL * 3072 * 2;
constexpr int NCHK = 258;
constexpr size_t GP_QT = 0;
constexpr size_t GP_KT = GP_QT + (size_t)NCHK * 4 * 2 * 64 * 128 * 2;
constexpr size_t GP_AM = GP_KT + (size_t)NCHK * 4 * 2 * 64 * 128 * 2;
constexpr size_t GP_VT = GP_AM + (size_t)NCHK * 4 * 2 * 64 * 64 * 2;
constexpr size_t GP_DC = GP_VT + (size_t)NCHK * 4 * 256 * 64 * 2;
constexpr size_t GP_U = GP_DC + (size_t)NCHK * 4 * 2 * 128 * 4;
constexpr size_t GP_D = GP_U + (size_t)16 * 4 * 2 * 128 * 256 * 4;
constexpr size_t GP_END = al256(GP_D + (size_t)16 * 4 * 2 * 128 * 4);
constexpr size_t O_V = O_GP + GP_END;
constexpr size_t O_QK = O_V + (size_t)RGMAX * 1024 * 2;
constexpr size_t O_OFB = O_QK + (size_t)RGMAX * 3072 * 2;
constexpr size_t O_OMLA = O_OFB + (size_t)NREAL * 2048 * 2;
constexpr size_t O_B4 = O_OMLA + (size_t)RGMAX * 1024 * 2;
constexpr size_t O_SMALL = O_B4 + (size_t)RGMAX * 256 * 2;
constexpr int S_ATTN = 0, S_QA = 1024, S_KVA = 1792, S_QN = 2048, S_KN = 2240, S_WAF = 2432, S_BAF = S_WAF + 8192, S_WAB = S_BAF + 512, S_BAB = S_WAB + 8192, S_GON = S_BAB + 512, S_FFN = S_GON + 256, S_END = S_FFN + 1024;
constexpr size_t O_BAR = al256(O_SMALL + (size_t)S_END * 4);
constexpr size_t WS_END = O_BAR + 3456 * 4;
constexpr size_t O_H = O_QK;
constexpr size_t O_B1 = O_QK + (size_t)RGMAX * 1024 * 2;
constexpr size_t O_B2 = O_OFB;
constexpr size_t O_KNR = O_OMLA;
constexpr size_t O_OGLA = O_GP + (size_t)NREAL * 1024 * 4;
constexpr size_t O_MIX = O_QK + (size_t)NREAL * 1024 * 2;
constexpr size_t O_H2 = O_QK + (size_t)NREAL * 2048 * 2;
constexpr size_t O_TMP = O_GP;
constexpr size_t O_ACT = O_GP;
static_assert(O_KNR + (size_t)RGMAX * 1024 * 2 <= O_B4 && (size_t)RGMAX * 1536 * 2 <= (size_t)NREAL * 1024 * 4, "overlay");
static_assert((size_t)RGMAX * 2048 * 2 <= (size_t)NREAL * 2048 * 2 + (size_t)RGMAX * 1024 * 2, "overlay b2");
static_assert((size_t)NREAL * 1024 * 4 + (size_t)NREAL * 1024 * 2 <= GP_END, "overlay ogla");
static_assert((size_t)NREAL * DFF * 2 <= GP_END && (size_t)NREAL * 1024 * 4 <= GP_END, "overlay act");
static_assert(WS_END <= (size_t)512 * 1024 * 1024, "workspace");

struct Params {
  const float *x_prompt, *x_sample, *meta, *attn_norm, *w_in, *q_a_norm, *w_uq, *kv_a_norm, *w_ukv, *q_norm, *k_norm, *w_o_mla,
      *w_a2_f, *b_a2_f, *w_a2_b, *b_a2_b, *gla_o_norm, *w_o_gla, *w_out, *ffn_norm, *w_gate, *w_up, *w_down;
  float* out; char* ws;
};

typedef __bf16 bf2_t __attribute__((ext_vector_type(2)));
typedef float f32x2_t __attribute__((ext_vector_type(2)));
__device__ __forceinline__ unsigned cvtpk(float lo, float hi) { f32x2_t v = {lo, hi}; bf2_t b = __builtin_convertvector(v, bf2_t); return *reinterpret_cast<unsigned*>(&b); }
__device__ __forceinline__ bf16_t f2bf(float f) { return (bf16_t)(cvtpk(f, 0.f) & 0xffffu); }
__device__ __forceinline__ float bf2f(bf16_t b) { return __uint_as_float(((unsigned)b) << 16); }
__device__ __forceinline__ float bflo(unsigned w) { return __uint_as_float(w << 16); }
__device__ __forceinline__ float bfhi(unsigned w) { return __uint_as_float(w & 0xffff0000u); }
__device__ __forceinline__ float wave_sum(float v) { for (int o = 32; o >= 1; o >>= 1) v += __shfl_xor(v, o); return v; }
__device__ __forceinline__ float sigmoidf_(float x) { return 1.f / (1.f + __expf(-x)); }
__device__ __forceinline__ void unpack8(u32x4 w, float* f) { f[0] = bflo(w.x); f[1] = bfhi(w.x); f[2] = bflo(w.y); f[3] = bfhi(w.y); f[4] = bflo(w.z); f[5] = bfhi(w.z); f[6] = bflo(w.w); f[7] = bfhi(w.w); }
__device__ __forceinline__ u32x4 pack8(const float* f) { u32x4 w; w.x = cvtpk(f[0], f[1]); w.y = cvtpk(f[2], f[3]); w.z = cvtpk(f[4], f[5]); w.w = cvtpk(f[6], f[7]); return w; }

template <class ColPtr>
__device__ void transpose_w(int K, long ld, bf16_t* dst, int Ndst, ColPtr colptr) {
  const int kb8 = K / 8; const long total = (long)(Ndst / 64) * kb8 * 64;
  for (long i = (long)BIDX() * NTHR + TIDX(); i < total; i += (long)gridDim.x * NTHR) {
    const int nl = (int)(i & 63); const long rest = i >> 6; const int kb = (int)(rest % kb8); const int nb = (int)(rest / kb8);
    const int n = nb * 64 + nl; const float* p = colptr(n);
    float v[8];
#pragma unroll
    for (int e = 0; e < 8; ++e) v[e] = p ? p[(long)(kb * 8 + e) * ld] : 0.f;
    *(u32x4*)(dst + (long)n * K + kb * 8) = pack8(v);
  }
}
__device__ void phase_weights(const Params& p) {
  char* ws = p.ws;
  { float* sm = (float*)(ws + O_SMALL); const int gi = BIDX() * NTHR + TIDX(), gs = gridDim.x * NTHR;
    for (int i = gi; i < 1024; i += gs) { sm[S_ATTN + i] = p.attn_norm[i]; sm[S_FFN + i] = p.ffn_norm[i]; }
    for (int i = gi; i < 768; i += gs) sm[S_QA + i] = p.q_a_norm[i];
    for (int i = gi; i < 256; i += gs) { sm[S_KVA + i] = p.kv_a_norm[i]; sm[S_GON + i] = p.gla_o_norm[i]; }
    for (int i = gi; i < 192; i += gs) { sm[S_QN + i] = p.q_norm[i]; sm[S_KN + i] = p.k_norm[i]; }
    for (int i = gi; i < 8192; i += gs) { sm[S_WAF + i] = p.w_a2_f[i]; sm[S_WAB + i] = p.w_a2_b[i]; }
    for (int i = gi; i < 512; i += gs) { sm[S_BAF + i] = p.b_a2_f[i]; sm[S_BAB + i] = p.b_a2_b[i]; } }
  { const float* w = p.w_in;
    transpose_w(1024, DIN, (bf16_t*)(ws + O_WIN), NIN, [=](int n) -> const float* {
      int o;
      if (n < 1024) o = n;
      else if (n < 2048) o = 1088 + (n - 1024);
      else if (n < 3072) o = 2112 + (n - 2048);
      else if (n < 4096) o = 3136 + (n - 3072);
      else if (n < 6144) o = 4192 + (n - 4096);
      else if (n < 6208) o = 1024 + (n - 6144);
      else if (n < 6240) o = 4160 + (n - 6208);
      else return nullptr;
      return w + o; }); }
  { const float* w = p.w_uq; transpose_w(768, 1536, (bf16_t*)(ws + O_WUQ), 1536, [=](int n) -> const float* { return w + n; }); }
  { const float* w = p.w_ukv; transpose_w(256, 2048, (bf16_t*)(ws + O_WUKV), 2048, [=](int n) -> const float* {
      return n < 1024 ? w + (n >> 7) * 256 + (n & 127) : w + ((n - 1024) >> 7) * 256 + 128 + (n & 127); }); }
  { const float* w = p.w_o_mla; transpose_w(1024, 1024, (bf16_t*)(ws + O_WOM), 1024, [=](int n) -> const float* { return w + n; }); }
  { const float* w = p.w_o_gla; transpose_w(1024, 1024, (bf16_t*)(ws + O_WOG), 1024, [=](int n) -> const float* { return w + n; }); }
  { const float* w = p.w_out; transpose_w(1024, 1024, (bf16_t*)(ws + O_WOUT), 1024, [=](int n) -> const float* { return w + n; }); }
  { const float* wg = p.w_gate; const float* wu = p.w_up;
    transpose_w(1024, DFF, (bf16_t*)(ws + O_WGU), 5632, [=](int n) -> const float* {
      const int q = n >> 3, i = n & 7; return i < 4 ? wg + q * 4 + i : wu + q * 4 + (i - 4); }); }
  { const float* w = p.w_down; transpose_w(DFF, 1024, (bf16_t*)(ws + O_WD), 1024, [=](int n) -> const float* { return w + n; }); }
}

struct Grp { const float* x; float* out; int nseq, Ls, RG; };
__device__ __forceinline__ Grp make_grp(const Params& p, int g) {
  Grp G; if (g == 0) { G.x = p.x_prompt; G.out = p.out; G.nseq = 2; G.Ls = 8192; }
  else { G.x = p.x_sample + (size_t)(g - 1) * NREAL * DM; G.out = p.out + (size_t)g * NREAL * DM; G.nseq = 1; G.Ls = 16384; }
  G.RG = NREAL + 256 * G.nseq; return G;
}

struct LArgs { char* ws; const float* x; float* out; const float* meta; int nseq; };
#define LPHASE __device__
LPHASE void rows_h(char* ws_, const float* x_, float* out_, const float* meta_, int nseq_) { struct { char* ws; const float* meta; } p; p.ws = ws_; p.meta = meta_; Grp G; G.x = x_; G.out = out_; G.nseq = nseq_; G.Ls = nseq_ == 2 ? 8192 : 16384; G.RG = NREAL + 256 * nseq_;
  const int tix = TIDX(), lane = tix & 63, gw = BIDX() * 8 + (tix >> 6), nw = gridDim.x * 8;
  bf16_t* h = (bf16_t*)(p.ws + O_H);
  for (int r = gw; r < G.RG; r += nw) {
    const float* xr = nullptr;
    if (r < NREAL) xr = G.x + (size_t)r * DM; else { const int i = (r - NREAL) & 255; if (i < 16) xr = p.meta + i * DM; }
    bf16_t* hr = h + (size_t)r * DM;
    if (!xr) {
#pragma unroll
      for (int q = 0; q < 4; ++q) *(u32x2*)(hr + q * 256 + lane * 4) = (u32x2){0u, 0u};
      continue; }
    f32x4 v[4]; float ss = 0.f;
#pragma unroll
    for (int q = 0; q < 4; ++q) { v[q] = *(const f32x4*)(xr + q * 256 + lane * 4); ss += v[q][0] * v[q][0] + v[q][1] * v[q][1] + v[q][2] * v[q][2] + v[q][3] * v[q][3]; }
    ss = wave_sum(ss); const float rs = rsqrtf(ss * (1.f / DM) + EPS);
#pragma unroll
    for (int q = 0; q < 4; ++q) { const f32x4 g = *(const f32x4*)((const float*)(p.ws + O_SMALL) + S_ATTN + q * 256 + lane * 4);
      u32x2 w; w.x = cvtpk(v[q][0] * rs * g[0], v[q][1] * rs * g[1]); w.y = cvtpk(v[q][2] * rs * g[2], v[q][3] * rs * g[3]);
      *(u32x2*)(hr + q * 256 + lane * 4) = w; }
  }
}
LPHASE void rows_h2(char* ws_, const float* x_, float* out_, const float* meta_, int nseq_) { struct { char* ws; const float* meta; } p; p.ws = ws_; p.meta = meta_; Grp G; G.x = x_; G.out = out_; G.nseq = nseq_; G.Ls = nseq_ == 2 ? 8192 : 16384; G.RG = NREAL + 256 * nseq_;
  const int tix = TIDX(), lane = tix & 63, gw = BIDX() * 8 + (tix >> 6), nw = gridDim.x * 8;
  bf16_t* h = (bf16_t*)(p.ws + O_H2);
  for (int r = gw; r < NREAL; r += nw) {
    const float* xr = G.out + (size_t)r * DM; bf16_t* hr = h + (size_t)r * DM;
    f32x4 v[4]; float ss = 0.f;
#pragma unroll
    for (int q = 0; q < 4; ++q) { v[q] = *(const f32x4*)(xr + q * 256 + lane * 4); ss += v[q][0] * v[q][0] + v[q][1] * v[q][1] + v[q][2] * v[q][2] + v[q][3] * v[q][3]; }
    ss = wave_sum(ss); const float rs = rsqrtf(ss * (1.f / DM) + EPS);
#pragma unroll
    for (int q = 0; q < 4; ++q) { const f32x4 g = *(const f32x4*)((const float*)(p.ws + O_SMALL) + S_FFN + q * 256 + lane * 4);
      u32x2 w; w.x = cvtpk(v[q][0] * rs * g[0], v[q][1] * rs * g[1]); w.y = cvtpk(v[q][2] * rs * g[2], v[q][3] * rs * g[3]);
      *(u32x2*)(hr + q * 256 + lane * 4) = w; }
  }
}
LPHASE void rows_cnorm(char* ws_, const float* x_, float* out_, const float* meta_, int nseq_) { struct { char* ws; const float* meta; } p; p.ws = ws_; p.meta = meta_; Grp G; G.x = x_; G.out = out_; G.nseq = nseq_; G.Ls = nseq_ == 2 ? 8192 : 16384; G.RG = NREAL + 256 * nseq_;
  const int tix = TIDX(), lane = tix & 63, gw = BIDX() * 8 + (tix >> 6), nw = gridDim.x * 8;
  bf16_t* b1 = (bf16_t*)(p.ws + O_B1);
  const int nmeta8 = 32 * nseq_;
  if (gw < nmeta8) return;
  for (int r = gw - nmeta8; r < G.RG; r += nw - nmeta8) {
    bf16_t* br = b1 + (size_t)r * 1024;
    float a[8], b[8]; unpack8(*(const u32x4*)(br + lane * 8), a); unpack8(*(const u32x4*)(br + 512 + lane * 8), b);
    float sa = 0.f, sb = 0.f;
#pragma unroll
    for (int e = 0; e < 8; ++e) { sa += a[e] * a[e]; sb += b[e] * b[e]; }
    float sq = sa + (lane < 32 ? sb : 0.f), skv = (lane < 32 ? 0.f : sb);
    sq = wave_sum(sq); skv = wave_sum(skv);
    const float rq = rsqrtf(sq * (1.f / 768.f) + EPS), rkv = rsqrtf(skv * (1.f / 256.f) + EPS);
    const float* smq = (const float*)(p.ws + O_SMALL) + S_QA; const float* gb = lane < 32 ? smq + 512 + lane * 8 : (const float*)(p.ws + O_SMALL) + S_KVA + (lane * 8 - 256); const float rb = lane < 32 ? rq : rkv;
#pragma unroll
    for (int e = 0; e < 8; ++e) { a[e] *= rq * smq[lane * 8 + e]; b[e] *= rb * gb[e]; }
    *(u32x4*)(br + lane * 8) = pack8(a); *(u32x4*)(br + 512 + lane * 8) = pack8(b);
  }
}
LPHASE void rows_qk(char* ws_, const float* x_, float* out_, const float* meta_, int nseq_) { struct { char* ws; const float* meta; } p; p.ws = ws_; p.meta = meta_; Grp G; G.x = x_; G.out = out_; G.nseq = nseq_; G.Ls = nseq_ == 2 ? 8192 : 16384; G.RG = NREAL + 256 * nseq_;
  const int tix = TIDX(), lane = tix & 63, gw = BIDX() * 8 + (tix >> 6), nw = gridDim.x * 8;
  const bf16_t* qraw = (const bf16_t*)G.out; const bf16_t* knr = (const bf16_t*)(p.ws + O_KNR); const bf16_t* b4 = (const bf16_t*)(p.ws + O_B4);
  bf16_t* Q = (bf16_t*)(p.ws + O_QK); bf16_t* Kb = Q + (size_t)RGMAX * 1536;
  const int ri = lane & 31;
  const float inv = __expf(-(float)(2 * ri) * (1.f / 64.f) * 9.210340371976184f);
  const float* smn = (const float*)(p.ws + O_SMALL);
  const float qn0 = smn[S_QN + lane], qn1 = smn[S_QN + 64 + lane], qn2 = smn[S_QN + 128 + lane];
  const float kn0 = smn[S_KN + lane], kn1 = smn[S_KN + 64 + lane], kn2 = smn[S_KN + 128 + lane];
  for (int r = gw; r < G.RG; r += nw) {
    int pos; if (r < NREAL) pos = 16 + (r % G.Ls); else pos = (r - NREAL) & 255;
    float sn, cs; sincosf((float)pos * inv, &sn, &cs);
    const float kr = bf2f(b4[(size_t)r * 256 + lane]);
    for (int h = 0; h < 8; ++h) {
      { const bf16_t* s = knr + (size_t)r * 1024 + h * 128; float e0 = bf2f(s[lane]), e1 = bf2f(s[64 + lane]), e2 = kr;
        float ss = wave_sum(e0 * e0 + e1 * e1 + e2 * e2); const float rs = rsqrtf(ss * (1.f / 192.f) + EPS);
        e0 *= rs * kn0; e1 *= rs * kn1; e2 *= rs * kn2; const float pr = __shfl_xor(e2, 32);
        const float o2 = lane < 32 ? e2 * cs - pr * sn : e2 * cs + pr * sn;
        bf16_t* d = Kb + (size_t)r * 1536 + h * 192; d[lane] = f2bf(e0); d[64 + lane] = f2bf(e1); d[128 + lane] = f2bf(o2); }
    }
  }
}
LPHASE void rows_ogla(char* ws_, const float* x_, float* out_, const float* meta_, int nseq_) { struct { char* ws; const float* meta; } p; p.ws = ws_; p.meta = meta_; Grp G; G.x = x_; G.out = out_; G.nseq = nseq_; G.Ls = nseq_ == 2 ? 8192 : 16384; G.RG = NREAL + 256 * nseq_;
  const int tix = TIDX(), lane = tix & 63, gw = BIDX() * 8 + (tix >> 6), nw = gridDim.x * 8;
  const bf16_t* of = (const bf16_t*)(p.ws + O_OFB); const bf16_t* ob = of + (size_t)NREAL * 1024;
  const bf16_t* g3 = (const bf16_t*)(p.ws + O_G3); bf16_t* og = (bf16_t*)(p.ws + O_OGLA);
  for (int r = gw; r < NREAL; r += nw) {
    float a[16], b[8];
    unpack8(*(const u32x4*)(of + (size_t)r * 1024 + lane * 16), a); unpack8(*(const u32x4*)(of + (size_t)r * 1024 + lane * 16 + 8), a + 8);
    unpack8(*(const u32x4*)(ob + (size_t)r * 1024 + lane * 16), b);
#pragma unroll
    for (int e = 0; e < 8; ++e) a[e] += b[e];
    unpack8(*(const u32x4*)(ob + (size_t)r * 1024 + lane * 16 + 8), b);
#pragma unroll
    for (int e = 0; e < 8; ++e) a[8 + e] += b[e];
    float ss = 0.f;
#pragma unroll
    for (int e = 0; e < 16; ++e) ss += a[e] * a[e];
    ss += __shfl_xor(ss, 1); ss += __shfl_xor(ss, 2); ss += __shfl_xor(ss, 4); ss += __shfl_xor(ss, 8);
    const float rs = rsqrtf(ss * (1.f / 256.f) + EPS);
    float gg[16]; unpack8(*(const u32x4*)(g3 + (size_t)r * 3072 + lane * 16), gg); unpack8(*(const u32x4*)(g3 + (size_t)r * 3072 + lane * 16 + 8), gg + 8);
    const float* gn = (const float*)(p.ws + O_SMALL) + S_GON + ((lane * 16) & 255);
#pragma unroll
    for (int e = 0; e < 16; ++e) a[e] = a[e] * rs * gn[e] * (gg[e] * sigmoidf_(gg[e]));
    *(u32x4*)(og + (size_t)r * 1024 + lane * 16) = pack8(a); *(u32x4*)(og + (size_t)r * 1024 + lane * 16 + 8) = pack8(a + 8);
  }
}

constexpr int BM = 256, BK = 64, HALF = 128, HTB = HALF * BK * 2, NXCD = 8, WGM = 8;
__device__ __forceinline__ int lds_byte(int r, int c) { const int st = (r >> 4) * 2 + (c >> 5), rr = r & 15, cc = c & 31, ob = rr * 64 + cc * 2; return st * 1024 + (ob ^ (((ob >> 9) & 1) << 5)); }
__device__ __forceinline__ void stage_rc(int b, int& R, int& C) { const int st = b / 1024, sb = b % 1024, swz = sb ^ (((sb >> 9) & 1) << 5); R = (st >> 1) * 16 + swz / 64; C = (st & 1) * 32 + (swz % 64) / 2; }
__device__ __forceinline__ int perm32(int rho) { const int n = rho >> 4, i = rho & 15; return 8 * (i >> 2) + 4 * n + (i & 3); }
struct Unit { int pm, pn, w; };
struct Gemm { const bf16_t* A; const bf16_t* Bt; int lda, ldb, M, N, K; const bf16_t* A2; const bf16_t* Bt2; };
struct StaticOrder {
  int nM, nN, nwg, G, c, ntot;
  __device__ void init(int M, int N, int G_, int c_, bool dual) { nM = M / BM; nN = N / BM; nwg = nM * nN; ntot = dual ? 2 * nwg : nwg; G = G_; c = c_; }
  __device__ bool next(int i, Unit& u) const {
    const long L = (long)i * G + c; if (L >= ntot) return false;
    u.w = L >= nwg ? 1 : 0;
    int wgid = (int)(L - (u.w ? nwg : 0)); { const int q = nwg / NXCD, r = nwg % NXCD, xcd = wgid % NXCD, off = wgid / NXCD; wgid = (xcd < r ? xcd * (q + 1) : r * (q + 1) + (xcd - r) * q) + off; }
    const int nig = WGM * nN, gid = wgid / nig, fm = gid * WGM, gsz = (nM - fm) < WGM ? (nM - fm) : WGM;
    u.pm = fm + ((wgid % nig) % gsz); u.pn = (wgid % nig) / gsz; return true;
  }
};
template <class Epi>
__device__ __forceinline__ void gemm_phase(LAS unsigned char* lds, const Gemm g, const Epi& E) {
  int tid_ = threadIdx.x; asm volatile("" : "+v"(tid_));
  const int tid = tid_, wid = __builtin_amdgcn_readfirstlane(tid >> 6), lane = tid & 63, wr = wid >> 2, wc = wid & 3, fr = lane & 15, fq = lane >> 4;
  const int K = g.K, nt = K / BK;
  StaticOrder S; S.init(g.M, g.N, gridDim.x, blockIdx.x, g.A2 != nullptr);
  unsigned voffA[2], voffB[2];
#pragma unroll
  for (int i = 0; i < 2; ++i) { int R, C; stage_rc(tid * 16 + i * 8192, R, C); const int Rb = (R & ~31) + perm32(R & 31);
    voffA[i] = (unsigned)(R * g.lda + C) * 2u; voffB[i] = (unsigned)(Rb * g.ldb + C) * 2u; }
  const size_t kstep = (size_t)(BK * 2);
  const size_t hstepA = (size_t)HALF * g.lda * 2, hstepB = (size_t)HALF * g.ldb * 2;
  const size_t tstepA = 2 * hstepA, tstepB = 2 * hstepB;
  const unsigned ldsw = (unsigned)wid * 1024u;
  const int aoff = lds_byte(wr * 64 + fr, fq * 8), boff = lds_byte(wc * 32 + fr, fq * 8);
#define PG8_SA(b, h) (((b) * 2 + (h)) * HTB)
#define PG8_SB(b, h) ((4 + (b) * 2 + (h)) * HTB)
#define PG8_STAGE(bufoff, gbase, voff) do { _Pragma("unroll") for (int _i = 0; _i < 2; ++_i) \
    __builtin_amdgcn_global_load_lds((const unsigned*)((const char*)(gbase) + (voff)[_i]), (LAS unsigned*)(lds + (bufoff) + ldsw + _i * 8192), 16, 0, 0); } while (0)
#define PG8_LDA(dst, b, h) do { _Pragma("unroll") for (int m = 0; m < 4; ++m) _Pragma("unroll") for (int k = 0; k < 2; ++k) dst[m][k] = *(const LAS bf16x8*)(lds + PG8_SA(b, h) + aoff + m * 2048 + k * 1024); } while (0)
#define PG8_LDB(dst, b, h) do { _Pragma("unroll") for (int n = 0; n < 2; ++n) _Pragma("unroll") for (int k = 0; k < 2; ++k) dst[n][k] = *(const LAS bf16x8*)(lds + PG8_SB(b, h) + boff + n * 2048 + k * 1024); } while (0)
#define PG8_MMA(ai, bj, At, Bt) do { __builtin_amdgcn_s_setprio(1); _Pragma("unroll") for (int m = 0; m < 4; ++m) _Pragma("unroll") for (int n = 0; n < 2; ++n) _Pragma("unroll") for (int k = 0; k < 2; ++k) \
    acc[ai][bj][m][n] = __builtin_amdgcn_mfma_f32_16x16x32_bf16(Bt[n][k], At[m][k], acc[ai][bj][m][n], 0, 0, 0); __builtin_amdgcn_s_setprio(0); } while (0)
#define PG8_WAIT_V(n) asm volatile("s_waitcnt vmcnt(" #n ")" ::: "memory")
#define PG8_WAIT_L(n) asm volatile("s_waitcnt lgkmcnt(" #n ")" ::: "memory")
#define PG8_BAR __builtin_amdgcn_s_barrier()
#define PG8_SCHED __builtin_amdgcn_sched_barrier(0)
  Unit cur, nxt; int ui = 0;
  if (!S.next(0, cur)) return;
  f32x4 acc[2][2][4][2];
#pragma unroll
  for (int a = 0; a < 2; ++a)
#pragma unroll
    for (int b = 0; b < 2; ++b)
#pragma unroll
      for (int m = 0; m < 4; ++m)
#pragma unroll
        for (int n = 0; n < 2; ++n) acc[a][b][m][n] = (f32x4){0.f, 0.f, 0.f, 0.f};
  bf16x8 At[4][2], B0[2][2], B1[2][2];
  const char* cA = (const char*)(cur.w ? g.A2 : g.A) + (size_t)cur.pm * tstepA; const char* cB = (const char*)(cur.w ? g.Bt2 : g.Bt) + (size_t)cur.pn * tstepB;
  PG8_STAGE(PG8_SB(0, 0), cB, voffB); PG8_STAGE(PG8_SA(0, 0), cA, voffA); PG8_STAGE(PG8_SB(0, 1), cB + hstepB, voffB); PG8_STAGE(PG8_SA(0, 1), cA + hstepA, voffA);
  if (wr == 1) PG8_BAR;
  PG8_WAIT_V(4); PG8_BAR;
  PG8_STAGE(PG8_SB(1, 0), cB + kstep, voffB); PG8_STAGE(PG8_SA(1, 0), cA + kstep, voffA); PG8_STAGE(PG8_SB(1, 1), cB + hstepB + kstep, voffB);
  PG8_WAIT_V(6); PG8_BAR;
  for (;;) {
    const bool has_next = S.next(ui + 1, nxt);
    const char* nA = has_next ? (const char*)(nxt.w ? g.A2 : g.A) + (size_t)nxt.pm * tstepA : cA; const char* nB = has_next ? (const char*)(nxt.w ? g.Bt2 : g.Bt) + (size_t)nxt.pn * tstepB : cB;
    for (int t = 0; t < nt; t += 2) {
      const bool last = (t == nt - 2);
      const char* a1 = cA + (size_t)(t + 1) * kstep;
      const char* a2 = last ? nA : cA + (size_t)(t + 2) * kstep; const char* b2 = last ? nB : cB + (size_t)(t + 2) * kstep;
      const char* a3 = a2 + kstep; const char* b3 = b2 + kstep;
      PG8_LDB(B0, 0, 0); PG8_SCHED; PG8_LDA(At, 0, 0); PG8_STAGE(PG8_SA(1, 1), a1 + hstepA, voffA);
      PG8_WAIT_L(8); PG8_BAR; PG8_WAIT_L(0); PG8_MMA(0, 0, At, B0); PG8_BAR; PG8_SCHED;
      PG8_LDB(B1, 0, 1); PG8_STAGE(PG8_SB(0, 0), b2, voffB);
      PG8_BAR; PG8_WAIT_L(0); PG8_MMA(0, 1, At, B1); PG8_BAR;
      PG8_LDA(At, 0, 1); PG8_STAGE(PG8_SA(0, 0), a2, voffA);
      PG8_BAR; PG8_WAIT_L(0); PG8_MMA(1, 0, At, B0); PG8_BAR; PG8_SCHED;
      PG8_STAGE(PG8_SB(0, 1), b2 + hstepB, voffB);
      PG8_WAIT_V(6); PG8_BAR; PG8_MMA(1, 1, At, B1); PG8_BAR;
      PG8_LDB(B0, 1, 0); PG8_SCHED; PG8_LDA(At, 1, 0); PG8_STAGE(PG8_SA(0, 1), a2 + hstepA, voffA);
      PG8_WAIT_L(8); PG8_BAR; PG8_WAIT_L(0); PG8_MMA(0, 0, At, B0); PG8_BAR; PG8_SCHED;
      PG8_LDB(B1, 1, 1); PG8_STAGE(PG8_SB(1, 0), b3, voffB);
      PG8_BAR; PG8_WAIT_L(0); PG8_MMA(0, 1, At, B1); PG8_BAR;
      PG8_LDA(At, 1, 1); PG8_STAGE(PG8_SA(1, 0), a3, voffA);
      PG8_BAR; PG8_WAIT_L(0); PG8_MMA(1, 0, At, B0); PG8_BAR; PG8_SCHED;
      PG8_STAGE(PG8_SB(1, 1), b3 + hstepB, voffB);
      PG8_WAIT_V(6); PG8_BAR; PG8_MMA(1, 1, At, B1); PG8_BAR;
    }
    {
#pragma unroll
      for (int ai = 0; ai < 2; ++ai)
#pragma unroll
        for (int m = 0; m < 4; ++m)
#pragma unroll
          for (int bj = 0; bj < 2; ++bj)
          { E.st2(cur.w, cur.pm * BM + ai * HALF + wr * 64 + m * 16 + fr, cur.pn * BM + bj * HALF + wc * 32 + 8 * fq, acc[ai][bj][m][0], acc[ai][bj][m][1]); if (bj == 1 && (m & 1)) asm volatile("" ::: "memory"); }
    }
    if (!has_next) break;
#pragma unroll
    for (int a = 0; a < 2; ++a)
#pragma unroll
      for (int b = 0; b < 2; ++b)
#pragma unroll
        for (int m = 0; m < 4; ++m)
#pragma unroll
          for (int n = 0; n < 2; ++n) acc[a][b][m][n] = (f32x4){0.f, 0.f, 0.f, 0.f};
    cur = nxt; cA = nA; cB = nB; ++ui;
  }
  PG8_WAIT_V(0);
  if (wr == 0) PG8_BAR;
  PG8_BAR;
#undef PG8_SA
#undef PG8_SB
#undef PG8_STAGE
#undef PG8_LDA
#undef PG8_LDB
#undef PG8_MMA
#undef PG8_WAIT_V
#undef PG8_WAIT_L
#undef PG8_BAR
#undef PG8_SCHED
}

__device__ __forceinline__ u32x4 pk8(f32x4 a, f32x4 b) { u32x4 w; w.x = cvtpk(a[0], a[1]); w.y = cvtpk(a[2], a[3]); w.z = cvtpk(b[0], b[1]); w.w = cvtpk(b[2], b[3]); return w; }
struct EpiInproj { bf16_t *b1, *b2, *g3, *b4;
  __device__ __forceinline__ void st(int r, int c, f32x4 v0, f32x4 v1) const {
    const u32x4 w = pk8(v0, v1);
    if (c < 1024) *(u32x4*)(b1 + (size_t)r * 1024 + c) = w;
    else if (c < 3072) *(u32x4*)(b2 + (size_t)r * 2048 + (c - 1024)) = w;
    else if (c < 6144) { if (r < NREAL) *(u32x4*)(g3 + (size_t)r * 3072 + (c - 3072)) = w; }
    else *(u32x4*)(b4 + (size_t)r * 256 + (c - 6144)) = w; } };
struct EpiBf16 { bf16_t* o; int ld;
  __device__ __forceinline__ void st(int r, int c, f32x4 v0, f32x4 v1) const { *(u32x4*)(o + (size_t)r * ld + c) = pk8(v0, v1); } };
struct EpiKV { bf16_t *kn, *v;
  __device__ __forceinline__ void st(int r, int c, f32x4 v0, f32x4 v1) const {
    if (c < 1024) *(u32x4*)(kn + (size_t)r * 1024 + c) = pk8(v0, v1); else *(u32x4*)(v + (size_t)r * 1024 + (c - 1024)) = pk8(v0, v1); } };
struct EpiGateA { const bf16_t* g3; bf16_t* tmp;
  __device__ __forceinline__ void st(int r, int c, f32x4 v0, f32x4 v1) const {
    float g[8]; unpack8(*(const u32x4*)(g3 + (size_t)r * 3072 + 1024 + c), g);
    f32x4 a, b;
#pragma unroll
    for (int e = 0; e < 4; ++e) { a[e] = v0[e] * sigmoidf_(g[e]); b[e] = v1[e] * sigmoidf_(g[4 + e]); }
    *(u32x4*)(tmp + (size_t)r * 1024 + c) = pk8(a, b); } };
struct EpiGateB { const bf16_t* g3; const bf16_t* tmp; bf16_t* m;
  __device__ __forceinline__ void st(int r, int c, f32x4 v0, f32x4 v1) const {
    float g[8]; unpack8(*(const u32x4*)(g3 + (size_t)r * 3072 + 2048 + c), g);
    float t[8]; unpack8(*(const u32x4*)(tmp + (size_t)r * 1024 + c), t);
    f32x4 a = (f32x4){t[0], t[1], t[2], t[3]}, b = (f32x4){t[4], t[5], t[6], t[7]};
#pragma unroll
    for (int e = 0; e < 4; ++e) { a[e] += v0[e] * sigmoidf_(g[e]); b[e] += v1[e] * sigmoidf_(g[4 + e]); }
    *(u32x4*)(m + (size_t)r * 1024 + c) = pk8(a, b); } };
struct EpiX1 { const float* x; float* out;
  __device__ __forceinline__ void st(int r, int c, f32x4 v0, f32x4 v1) const {
    const f32x4 a = __builtin_nontemporal_load((const f32x4*)(x + (size_t)r * 1024 + c)), b = __builtin_nontemporal_load((const f32x4*)(x + (size_t)r * 1024 + c + 4));
    *(f32x4*)(out + (size_t)r * 1024 + c) = a + v0; *(f32x4*)(out + (size_t)r * 1024 + c + 4) = b + v1; } };
struct EpiFfnUp { bf16_t* act;
  __device__ __forceinline__ void st(int r, int c, f32x4 v0, f32x4 v1) const {
    float o[4];
#pragma unroll
    for (int e = 0; e < 4; ++e) o[e] = v0[e] * sigmoidf_(v0[e]) * v1[e];
    u32x2 w; w.x = cvtpk(o[0], o[1]); w.y = cvtpk(o[2], o[3]); *(u32x2*)(act + (size_t)r * DFF + (c >> 1)) = w; } };
struct EpiFfnDown { float* out;
  __device__ __forceinline__ void st(int r, int c, f32x4 v0, f32x4 v1) const {
    float* o = out + (size_t)r * 1024 + c; const f32x4 a = __builtin_nontemporal_load((const f32x4*)o), b = __builtin_nontemporal_load((const f32x4*)(o + 4));
    __builtin_nontemporal_store(a + v0, (f32x4*)o); __builtin_nontemporal_store(b + v1, (f32x4*)(o + 4)); } };

constexpr int LDQ = 1536, LDK = 1536, LDV = 1024, LDO = 1024;
constexpr int SHM_V = 64 * 128 * 2, SHM_K = 64 * 192 * 2;
constexpr float ATT_SCALE = 0.07216878364870322f;
constexpr float ATT_THR = 8.f;
#define KSWZ(row, colB) ((row) * 384 + ((colB) ^ (((row) & 7) << 4)))
__device__ __forceinline__ int crow(int r, int hi) { return (r & 3) + 8 * (r >> 2) + 4 * hi; }
__device__ __forceinline__ void partialSM(f32x16& p0, f32x16& p1, float& m_reg, float& mn, float& alpha) {
  constexpr float C = ATT_SCALE * 1.4426950408889634f;
  float pmax = p0[0];
#pragma unroll
  for (int r = 1; r < 16; ++r) pmax = fmaxf(pmax, p0[r]);
#pragma unroll
  for (int r = 0; r < 16; ++r) pmax = fmaxf(pmax, p1[r]);
  { auto rr = __builtin_amdgcn_permlane32_swap(__float_as_uint(pmax), __float_as_uint(pmax), false, false);
    pmax = fmaxf(__uint_as_float(rr[0]), __uint_as_float(rr[1])); }
  if (__builtin_expect(__all(pmax - m_reg <= ATT_THR / ATT_SCALE), 1)) { mn = m_reg; alpha = 1.f; }
  else { mn = fmaxf(m_reg, pmax); alpha = __builtin_amdgcn_exp2f((m_reg - mn) * C); m_reg = mn; }
  const float mnC = -mn * C;
#pragma unroll
  for (int r = 0; r < 16; ++r) p0[r] = fmaf(p0[r], C, mnC);
#pragma unroll
  for (int r = 0; r < 16; ++r) p1[r] = fmaf(p1[r], C, mnC);
#pragma unroll
  for (int r = 0; r < 16; ++r) p0[r] = __builtin_amdgcn_exp2f(p0[r]);
}
__device__ __forceinline__ void finishSM(f32x16& p0, f32x16& p1, float alpha, float& l_reg, bf16x8& pa0, bf16x8& pa1, bf16x8& pa2, bf16x8& pa3) {
#pragma unroll
  for (int r = 0; r < 16; ++r) p1[r] = __builtin_amdgcn_exp2f(p1[r]);
  float ps = 0;
#pragma unroll
  for (int r = 0; r < 16; ++r) ps += p0[r];
#pragma unroll
  for (int r = 0; r < 16; ++r) ps += p1[r];
  { auto rr = __builtin_amdgcn_permlane32_swap(__float_as_uint(ps), __float_as_uint(ps), false, false);
    ps = __uint_as_float(rr[0]) + __uint_as_float(rr[1]); }
  l_reg = l_reg * alpha + ps;
#define PK4(P, BASE, OUT) do { unsigned a0 = cvtpk(P[BASE + 0], P[BASE + 1]), a1 = cvtpk(P[BASE + 2], P[BASE + 3]);   \
    unsigned b0 = cvtpk(P[BASE + 4], P[BASE + 5]), b1 = cvtpk(P[BASE + 6], P[BASE + 7]);                              \
    auto r0 = __builtin_amdgcn_permlane32_swap(a0, b0, false, false); auto r1 = __builtin_amdgcn_permlane32_swap(a1, b1, false, false); \
    u32x4 w = {r0[0], r1[0], r0[1], r1[1]}; OUT = *reinterpret_cast<bf16x8*>(&w); } while (0)
  PK4(p0, 0, pa0); PK4(p0, 8, pa1); PK4(p1, 0, pa2); PK4(p1, 8, pa3);
#undef PK4
}
__device__ __forceinline__ void qkt(f32x16& p0, f32x16& p1, const char* Ks, const bf16x8* qr, const char* qx, int r32, int hi, int mode) {
  p0 = f32x16{}; p1 = f32x16{};
#pragma unroll
  for (int d0 = 0; d0 < 12; ++d0) { const int cb = (d0 * 16 + hi * 8) * 2;
    bf16x8 b0 = *reinterpret_cast<const bf16x8*>(Ks + KSWZ(r32, cb));
    bf16x8 b1 = *reinterpret_cast<const bf16x8*>(Ks + KSWZ(32 + r32, cb));
    const bf16x8 qf = d0 < 8 ? qr[d0 < 8 ? d0 : 0] : *reinterpret_cast<const bf16x8*>(qx + (d0 - 8) * 1024);
    p0 = __builtin_amdgcn_mfma_f32_32x32x16_bf16(b0, qf, p0, 0, 0, 0);
    p1 = __builtin_amdgcn_mfma_f32_32x32x16_bf16(b1, qf, p1, 0, 0, 0); }
  if (mode != 0) {
    constexpr float NEG = -1e30f;
#pragma unroll
    for (int r = 0; r < 16; ++r) p1[r] = NEG;
#pragma unroll
    for (int r = 8; r < 16; ++r) p0[r] = NEG;
    if (mode == 2) {
#pragma unroll
      for (int r = 0; r < 8; ++r) p0[r] = NEG; }
  }
}
__device__ __forceinline__ int v_st(int k, int c) { const int kk = (k & ~0xC) | ((k & 4) << 1) | ((k & 8) >> 1); return ((kk >> 3) * 4 + (c >> 5)) * 512 + ((kk & 7) * 32 + (c & 31)) * 2; }
__device__ __forceinline__ int v_rd_base(int lane) { return ((lane & 3) << 3) | (((lane >> 2) & 3) << 6) | (((lane >> 4) & 1) << 5) | (((lane >> 5) & 1) << 8); }
constexpr int v_rd_off(int d0, int ks, int half) { return d0 * 512 + ks * 4096 + half * 2048; }
template <int OFF> __device__ __forceinline__ s16x4 tr_read(int vb) {
  s16x4 r; asm volatile("ds_read_b64_tr_b16 %0, %1 offset:%2" : "=&v"(r) : "v"(vb), "i"(OFF) : "memory"); return r;
}
template <int D0> __device__ __forceinline__ void pv_one(f32x16& od, int vb, bf16x8 pa0, bf16x8 pa1, bf16x8 pa2, bf16x8 pa3) {
  const s16x4 l0 = tr_read<v_rd_off(D0, 0, 0)>(vb), h0 = tr_read<v_rd_off(D0, 0, 1)>(vb), l1 = tr_read<v_rd_off(D0, 1, 0)>(vb), h1 = tr_read<v_rd_off(D0, 1, 1)>(vb);
  const s16x4 l2 = tr_read<v_rd_off(D0, 2, 0)>(vb), h2 = tr_read<v_rd_off(D0, 2, 1)>(vb), l3 = tr_read<v_rd_off(D0, 3, 0)>(vb), h3 = tr_read<v_rd_off(D0, 3, 1)>(vb);
  asm volatile("s_waitcnt lgkmcnt(0)" ::: "memory"); SBAR();
#define PK(L, H) (bf16x8){L[0], L[1], L[2], L[3], H[0], H[1], H[2], H[3]}
  od = __builtin_amdgcn_mfma_f32_32x32x16_bf16(pa0, PK(l0, h0), od, 0, 0, 0);
  od = __builtin_amdgcn_mfma_f32_32x32x16_bf16(pa1, PK(l1, h1), od, 0, 0, 0);
  od = __builtin_amdgcn_mfma_f32_32x32x16_bf16(pa2, PK(l2, h2), od, 0, 0, 0);
  od = __builtin_amdgcn_mfma_f32_32x32x16_bf16(pa3, PK(l3, h3), od, 0, 0, 0);
#undef PK
}
__device__ __forceinline__ void pv_d0(f32x16* o, int vb, bf16x8 pa0, bf16x8 pa1, bf16x8 pa2, bf16x8 pa3) {
  pv_one<0>(o[0], vb, pa0, pa1, pa2, pa3); pv_one<1>(o[1], vb, pa0, pa1, pa2, pa3); pv_one<2>(o[2], vb, pa0, pa1, pa2, pa3); pv_one<3>(o[3], vb, pa0, pa1, pa2, pa3);
}
__device__ __forceinline__ void attn_body(const bf16_t* __restrict__ Qb, const bf16_t* __restrict__ Kh, const bf16_t* __restrict__ Vh,
                                          bf16_t* __restrict__ Ob, int krow0, int mrow0, int ntr, char* lds, int pos0, const float* __restrict__ qn) {
  int tid_ = threadIdx.x; asm volatile("" : "+v"(tid_));
  const int tid = tid_, wid = tid >> 6, lane = tid & 63, r32 = lane & 31, hi = lane >> 5;
  char* V_lds = lds; char* K_lds = lds + 2 * SHM_V;
  float* wsf = (float*)(lds + 2 * SHM_V + 2 * SHM_K) + wid * 64; float* li_l = wsf; float* al_l = wsf + 32;
  bf16x8 qr[8];
  char* qx = lds + 2 * SHM_V + 2 * SHM_K + 2048 + wid * 4096 + lane * 16;
  {
    float csv[16], snv[16];
    { const float posf = (float)(pos0 + wid * 32 + r32);
#pragma unroll
      for (int k = 0; k < 16; ++k) { const int i = 16 * (k >> 3) + 8 * hi + (k & 7);
        const float inv = __expf(-(float)(2 * i) * (1.f / 64.f) * 9.210340371976184f);
        sincosf(posf * inv, &snv[k], &csv[k]); asm volatile("" : "+v"(snv[k]), "+v"(csv[k])); } }
    const bf16_t* Qw = Qb + (long)(wid * 32 + r32) * LDQ + hi * 8;
    float xf[12][8]; float ss = 0.f;
#pragma unroll
    for (int d0 = 0; d0 < 12; ++d0) { unpack8(*reinterpret_cast<const u32x4*>(Qw + d0 * 16), xf[d0]);
#pragma unroll
      for (int e = 0; e < 8; ++e) ss += xf[d0][e] * xf[d0][e]; }
    ss += __shfl_xor(ss, 32);
    const float rs = rsqrtf(ss * (1.f / 192.f) + EPS);
#pragma unroll
    for (int d0 = 0; d0 < 12; ++d0) { const f32x4 g0 = *(const f32x4*)(qn + d0 * 16 + hi * 8), g1 = *(const f32x4*)(qn + d0 * 16 + hi * 8 + 4);
#pragma unroll
      for (int e = 0; e < 4; ++e) { xf[d0][e] *= rs * g0[e]; xf[d0][4 + e] *= rs * g1[e]; } }
#pragma unroll
    for (int dd = 0; dd < 2; ++dd)
#pragma unroll
      for (int e = 0; e < 8; ++e) { const float sn = snv[8 * dd + e], cs = csv[8 * dd + e];
        const float x1 = xf[8 + dd][e], x2 = xf[10 + dd][e];
        xf[8 + dd][e] = x1 * cs - x2 * sn; xf[10 + dd][e] = x2 * cs + x1 * sn; }
#pragma unroll
    for (int d0 = 0; d0 < 8; ++d0) { const u32x4 w = pack8(xf[d0]); qr[d0] = *reinterpret_cast<const bf16x8*>(&w); }
#pragma unroll
    for (int d0 = 8; d0 < 12; ++d0) *reinterpret_cast<u32x4*>(qx + (d0 - 8) * 1024) = pack8(xf[d0]);
  }
  float m_reg = -1e30f, l_reg = 0; f32x16 o[4] = {};
  const int sr = tid >> 4, sc = (tid & 15) * 8, vst0 = v_st(sr, sc), vst1 = v_st(32 + sr, sc);
  const int kr2 = tid >> 3, kc2 = 128 + (tid & 7) * 8;
  const int vb0 = (int)(uintptr_t)V_lds + v_rd_base(lane);
  const int NT = ntr + 2;
  bf16x8 vs0, vs1, ks0, ks1, ks2;
#define TROW(j) ((j) < ntr ? krow0 + (j) * 64 : mrow0 + ((j) - ntr) * 64)
  const unsigned voV = (unsigned)(sr * LDV + sc) * 2u, voK = (unsigned)(sr * LDK + sc) * 2u, voK2 = (unsigned)(kr2 * LDK + kc2) * 2u;
#define SLOAD(j) do { const long _k0 = TROW(j); const char* _vt = (const char*)Vh + _k0 * (LDV * 2); const char* _kt = (const char*)Kh + _k0 * (LDK * 2); \
    vs0 = *reinterpret_cast<const bf16x8*>(_vt + voV); vs1 = *reinterpret_cast<const bf16x8*>(_vt + 32 * LDV * 2 + voV); \
    ks0 = *reinterpret_cast<const bf16x8*>(_kt + voK); ks1 = *reinterpret_cast<const bf16x8*>(_kt + 32 * LDK * 2 + voK); \
    ks2 = *reinterpret_cast<const bf16x8*>(_kt + voK2); } while (0)
#define SWRITE(b) do { *(bf16x8*)(V_lds + (b) * SHM_V + vst0) = vs0; *(bf16x8*)(V_lds + (b) * SHM_V + vst1) = vs1; const int kc = sc * 2; \
    *(bf16x8*)(K_lds + (b) * SHM_K + KSWZ(sr, kc)) = ks0; *(bf16x8*)(K_lds + (b) * SHM_K + KSWZ(32 + sr, kc)) = ks1; \
    *(bf16x8*)(K_lds + (b) * SHM_K + KSWZ(kr2, kc2 * 2)) = ks2; } while (0)
#define SWAIT() asm volatile("s_waitcnt vmcnt(0)" ::: "memory")
#define RESC(a) do { if (__any((a) < 1.f)) { if (hi == 0) al_l[r32] = (a); asm volatile("s_waitcnt lgkmcnt(0)" ::: "memory"); \
    for (int d = 0; d < 4; ++d) for (int r = 0; r < 16; ++r) o[d][r] *= al_l[crow(r, hi)]; } } while (0)
  f32x16 pA0, pA1, pB0, pB1; float mnA, mnB, alA, alB; bf16x8 pa0, pa1, pa2, pa3;
  SLOAD(0); SWAIT(); SWRITE(0); __syncthreads();
  qkt(pA0, pA1, K_lds, qr, qx, r32, hi, 0); partialSM(pA0, pA1, m_reg, mnA, alA);
  SLOAD(1);
  SWAIT(); SWRITE(1); __syncthreads();
  for (int j = 1; j + 1 < NT; j += 2) {
    SBAR(); qkt(pB0, pB1, K_lds + SHM_K, qr, qx, r32, hi, 0);
    finishSM(pA0, pA1, alA, l_reg, pa0, pa1, pa2, pa3); SBAR();
    SLOAD(j + 1); SBAR();
    pv_d0(o, vb0, pa0, pa1, pa2, pa3); partialSM(pB0, pB1, m_reg, mnB, alB);
    __syncthreads(); SWAIT(); SWRITE(0);
    RESC(alB); __syncthreads();
    SBAR(); qkt(pA0, pA1, K_lds, qr, qx, r32, hi, (j + 1 == ntr) ? 1 : 0);
    finishSM(pB0, pB1, alB, l_reg, pa0, pa1, pa2, pa3); SBAR();
    SLOAD(j + 2); SBAR();
    pv_d0(o, vb0 + SHM_V, pa0, pa1, pa2, pa3); partialSM(pA0, pA1, m_reg, mnA, alA);
    __syncthreads(); SWAIT(); SWRITE(1);
    RESC(alA); __syncthreads();
  }
  SBAR(); qkt(pB0, pB1, K_lds + SHM_K, qr, qx, r32, hi, 2);
  finishSM(pA0, pA1, alA, l_reg, pa0, pa1, pa2, pa3); SBAR();
  pv_d0(o, vb0, pa0, pa1, pa2, pa3); partialSM(pB0, pB1, m_reg, mnB, alB);
  __syncthreads(); RESC(alB);
  finishSM(pB0, pB1, alB, l_reg, pa0, pa1, pa2, pa3); SBAR();
  pv_d0(o, vb0 + SHM_V, pa0, pa1, pa2, pa3);
  if (hi == 0) li_l[r32] = l_reg; asm volatile("s_waitcnt lgkmcnt(0)" ::: "memory");
  float rli[16];
#pragma unroll
  for (int r = 0; r < 16; ++r) rli[r] = __builtin_amdgcn_rcpf(li_l[crow(r, hi)]);
  bf16_t* Ow = Ob + (long)(wid * 32) * LDO;
#pragma unroll
  for (int r = 0; r < 16; ++r) { const int orow = crow(r, hi);
#pragma unroll
    for (int d0 = 0; d0 < 4; ++d0) Ow[(long)orow * LDO + d0 * 32 + r32] = f2bf(o[d0][r] * rli[r]); }
  __syncthreads();
#undef TROW
#undef SLOAD
#undef SWRITE
#undef SWAIT
#undef RESC
}
__device__ __forceinline__ void qkt12(f32x16& p0, f32x16& p1, const char* Ks, const bf16x8* qr, int r32, int hi, int mode) {
  p0 = f32x16{}; p1 = f32x16{};
#pragma unroll
  for (int d0 = 0; d0 < 12; ++d0) { const int cb = (d0 * 16 + hi * 8) * 2;
    bf16x8 b0 = *reinterpret_cast<const bf16x8*>(Ks + KSWZ(r32, cb));
    bf16x8 b1 = *reinterpret_cast<const bf16x8*>(Ks + KSWZ(32 + r32, cb));
    p0 = __builtin_amdgcn_mfma_f32_32x32x16_bf16(b0, qr[d0], p0, 0, 0, 0);
    p1 = __builtin_amdgcn_mfma_f32_32x32x16_bf16(b1, qr[d0], p1, 0, 0, 0); }
  if (mode != 0) {
    constexpr float NEG = -1e30f;
#pragma unroll
    for (int r = 0; r < 16; ++r) p1[r] = NEG;
#pragma unroll
    for (int r = 8; r < 16; ++r) p0[r] = NEG;
    if (mode == 2) {
#pragma unroll
      for (int r = 0; r < 8; ++r) p0[r] = NEG; }
  }
}
constexpr int A2_K = 2 * SHM_V, A2_WS = A2_K + 2 * SHM_K;
__device__ __forceinline__ void attn_body2(const bf16_t* __restrict__ Qb, const bf16_t* __restrict__ Kh, const bf16_t* __restrict__ Vh,
                                           bf16_t* __restrict__ Ob, int krow0, int mrow0, int ntr, char* lds, LAS unsigned char* ldsL, int pos0, const float* __restrict__ qn) {
  int tid_ = threadIdx.x; asm volatile("" : "+v"(tid_));
  const int tid = tid_, wid = __builtin_amdgcn_readfirstlane(tid >> 6), lane = tid & 63, r32 = lane & 31, hi = lane >> 5;
  char* V_lds = lds; char* K_lds = lds + A2_K;
  float* wsf = (float*)(lds + A2_WS) + wid * 64; float* li_l = wsf; float* al_l = wsf + 32;
  bf16x8 qr[8];
  char* qx = lds + A2_WS + 2048 + wid * 4096 + lane * 16;
  { float csv[16], snv[16];
    { const float posf = (float)(pos0 + wid * 32 + r32);
#pragma unroll
      for (int k = 0; k < 16; ++k) { const int i = 16 * (k >> 3) + 8 * hi + (k & 7);
        const float inv = __expf(-(float)(2 * i) * (1.f / 64.f) * 9.210340371976184f);
        sincosf(posf * inv, &snv[k], &csv[k]); asm volatile("" : "+v"(snv[k]), "+v"(csv[k])); } }
    const bf16_t* Qw = Qb + (long)(wid * 32 + r32) * LDQ + hi * 8;
    float xf[12][8]; float ss = 0.f;
#pragma unroll
    for (int d0 = 0; d0 < 12; ++d0) { unpack8(*reinterpret_cast<const u32x4*>(Qw + d0 * 16), xf[d0]);
#pragma unroll
      for (int e = 0; e < 8; ++e) ss += xf[d0][e] * xf[d0][e]; }
    ss += __shfl_xor(ss, 32);
    const float rs = rsqrtf(ss * (1.f / 192.f) + EPS);
#pragma unroll
    for (int d0 = 0; d0 < 12; ++d0) { const f32x4 g0 = *(const f32x4*)(qn + d0 * 16 + hi * 8), g1 = *(const f32x4*)(qn + d0 * 16 + hi * 8 + 4);
#pragma unroll
      for (int e = 0; e < 4; ++e) { xf[d0][e] *= rs * g0[e]; xf[d0][4 + e] *= rs * g1[e]; } }
#pragma unroll
    for (int dd = 0; dd < 2; ++dd)
#pragma unroll
      for (int e = 0; e < 8; ++e) { const float sn = snv[8 * dd + e], cs = csv[8 * dd + e];
        const float x1 = xf[8 + dd][e], x2 = xf[10 + dd][e];
        xf[8 + dd][e] = x1 * cs - x2 * sn; xf[10 + dd][e] = x2 * cs + x1 * sn; }
#pragma unroll
    for (int d0 = 0; d0 < 8; ++d0) { const u32x4 w = pack8(xf[d0]); qr[d0] = *reinterpret_cast<const bf16x8*>(&w); }
#pragma unroll
    for (int d0 = 8; d0 < 12; ++d0) *reinterpret_cast<u32x4*>(qx + (d0 - 8) * 1024) = pack8(xf[d0]);
  }
  float m_reg = -1e30f, l_reg = 0; f32x16 o[4] = {};
  unsigned okk[3], ovv[2];
#pragma unroll
  for (int i = 0; i < 3; ++i) { const int sl = (wid * 3 + i) * 64 + lane, row = sl / 24, cp = sl - row * 24, ch = cp ^ (row & 7); okk[i] = (unsigned)(row * (LDK * 2) + ch * 16); }
#pragma unroll
  for (int i = 0; i < 2; ++i) { const int sl = (wid * 2 + i) * 64 + lane, sub = sl >> 5, kk = (sub >> 2) * 8 + ((sl & 31) >> 2), c = (sub & 3) * 32 + (sl & 3) * 8;
    const int k = (kk & ~0xC) | ((kk & 4) << 1) | ((kk & 8) >> 1); ovv[i] = (unsigned)(k * (LDV * 2) + c * 2); }
  const int vb0 = (int)(uintptr_t)V_lds + v_rd_base(lane);
  const int NT = ntr + 2;
#define TROW(j) ((j) < ntr ? krow0 + (j) * 64 : mrow0 + ((j) - ntr) * 64)
#define ISSUE_K(j, stg) do { const long _k0 = TROW(j); const char* _kt = (const char*)Kh + _k0 * (LDK * 2); _Pragma("unroll") for (int _i = 0; _i < 3; ++_i) \
    __builtin_amdgcn_global_load_lds((const unsigned*)(_kt + okk[_i]), (LAS unsigned*)(ldsL + A2_K + (stg) * SHM_K + (wid * 3 + _i) * 1024), 16, 0, 0); } while (0)
#define ISSUE_V(j, stg) do { const long _k0 = TROW(j); const char* _vt = (const char*)Vh + _k0 * (LDV * 2); _Pragma("unroll") for (int _i = 0; _i < 2; ++_i) \
    __builtin_amdgcn_global_load_lds((const unsigned*)(_vt + ovv[_i]), (LAS unsigned*)(ldsL + (stg) * SHM_V + (wid * 2 + _i) * 1024), 16, 0, 0); } while (0)
#define WAITV(n) asm volatile("s_waitcnt vmcnt(" #n ")" ::: "memory")
#define ABAR() do { asm volatile("s_waitcnt lgkmcnt(0)" ::: "memory"); __builtin_amdgcn_s_barrier(); asm volatile("" ::: "memory"); } while (0)
#define RESC(a) do { if (__any((a) < 1.f)) { if (hi == 0) al_l[r32] = (a); asm volatile("s_waitcnt lgkmcnt(0)" ::: "memory"); \
    for (int d = 0; d < 4; ++d) for (int r = 0; r < 16; ++r) o[d][r] *= al_l[crow(r, hi)]; } } while (0)
  f32x16 pA0, pA1, pB0, pB1; float mnA, mnB, alA, alB; bf16x8 pa0, pa1, pa2, pa3;
  ISSUE_K(0, 0);
  WAITV(0); ABAR();
  ISSUE_K(1, 1); ISSUE_V(0, 0);
  qkt(pA0, pA1, K_lds, qr, qx, r32, hi, 0); partialSM(pA0, pA1, m_reg, mnA, alA);
  WAITV(0); ABAR();
  for (int j = 1; j + 1 < NT; j += 2) {
    ISSUE_K(j + 1, 0); ISSUE_V(j, 1);
    SBAR(); qkt(pB0, pB1, K_lds + SHM_K, qr, qx, r32, hi, 0);
    finishSM(pA0, pA1, alA, l_reg, pa0, pa1, pa2, pa3); SBAR();
    pv_d0(o, vb0, pa0, pa1, pa2, pa3); partialSM(pB0, pB1, m_reg, mnB, alB);
    RESC(alB); WAITV(0); ABAR();
    ISSUE_K(j + 2, 1); ISSUE_V(j + 1, 0);
    SBAR(); qkt(pA0, pA1, K_lds, qr, qx, r32, hi, (j + 1 == ntr) ? 1 : 0);
    finishSM(pB0, pB1, alB, l_reg, pa0, pa1, pa2, pa3); SBAR();
    pv_d0(o, vb0 + SHM_V, pa0, pa1, pa2, pa3); partialSM(pA0, pA1, m_reg, mnA, alA);
    RESC(alA); WAITV(0); ABAR();
  }
  ISSUE_V(NT - 1, 1);
  SBAR(); qkt(pB0, pB1, K_lds + SHM_K, qr, qx, r32, hi, 2);
  finishSM(pA0, pA1, alA, l_reg, pa0, pa1, pa2, pa3); SBAR();
  pv_d0(o, vb0, pa0, pa1, pa2, pa3); partialSM(pB0, pB1, m_reg, mnB, alB);
  WAITV(0); ABAR(); RESC(alB);
  finishSM(pB0, pB1, alB, l_reg, pa0, pa1, pa2, pa3); SBAR();
  pv_d0(o, vb0 + SHM_V, pa0, pa1, pa2, pa3);
  if (hi == 0) li_l[r32] = l_reg; asm volatile("s_waitcnt lgkmcnt(0)" ::: "memory");
  float rli[16];
#pragma unroll
  for (int r = 0; r < 16; ++r) rli[r] = __builtin_amdgcn_rcpf(li_l[crow(r, hi)]);
  bf16_t* Ow = Ob + (long)(wid * 32) * LDO;
#pragma unroll
  for (int r = 0; r < 16; ++r) { const int orow = crow(r, hi);
#pragma unroll
    for (int d0 = 0; d0 < 4; ++d0) Ow[(long)orow * LDO + d0 * 32 + r32] = f2bf(o[d0][r] * rli[r]); }
  ABAR();
#undef TROW
#undef ISSUE_K
#undef ISSUE_V
#undef WAITV
#undef ABAR
#undef RESC
}
__device__ void phase_attn(const Params& p0, const Grp& G, char* lds, LAS unsigned char* ldsL) { Params p = p0; p.ws = opaque(p0.ws);
  const bf16_t* Q = (const bf16_t*)G.out;
  const bf16_t* Kb = (const bf16_t*)(p.ws + O_QK) + (size_t)RGMAX * 1536; const bf16_t* Vb = (const bf16_t*)(p.ws + O_V);
  const float* qn = (const float*)(p.ws + O_SMALL) + S_QN;
  bf16_t* O = (bf16_t*)(p.ws + O_OMLA);
  const int nqb = G.Ls / 256;
  const int nitems = G.nseq * 8 * nqb;
  for (int it = BIDX(); it < nitems; it += gridDim.x) {
    const int h = it & 7, rest = it >> 3, s = rest / nqb, qb = rest % nqb;
    const int qrow = s * G.Ls + qb * 256;
#ifdef ATTN_REGSTAGE
    attn_body(Q + (size_t)qrow * LDQ + h * 192, Kb + h * 192, Vb + h * 128, O + (size_t)qrow * LDO + h * 128, s * G.Ls, NREAL + 256 * s, G.Ls / 64, lds, 16 + qb * 256, qn);
#else
    attn_body2(Q + (size_t)qrow * LDQ + h * 192, Kb + h * 192, Vb + h * 128, O + (size_t)qrow * LDO + h * 128, s * G.Ls, NREAL + 256 * s, G.Ls / 64, lds, ldsL, 16 + qb * 256, qn);
#endif
  }
}

constexpr int LGP = 129;
__device__ __forceinline__ float logsigmoidf_(float x) { return fminf(x, 0.f) - log1pf(__expf(-fabsf(x))); }
LPHASE void phase_gla_prep(char* ws_, const float* x_, float* out_, const float* meta_, int nseq_, char* lds) {
  const int tid0 = TIDX();
  char* wsp = opaque(ws_);
  const bf16_t* b2 = (const bf16_t*)(wsp + O_B2); const bf16_t* b4 = (const bf16_t*)(wsp + O_B4);
  char* gp = wsp + O_GP;
  float* lgF = (float*)lds; float* lgB = lgF + 64 * LGP;
  char* R2 = lds + 2 * 64 * LGP * 4;
  bf16_t* qhF = (bf16_t*)R2; bf16_t* khF = qhF + 64 * 128; bf16_t* qhB = khF + 64 * 128; bf16_t* khB = qhB + 64 * 128;
  float* af = (float*)R2;
  bf16_t* vt = (bf16_t*)(R2 + 8192);
  float* tot = (float*)(R2 + 65536);
  const float* smg = (const float*)(wsp + O_SMALL);
  const int nmeta = 4 * nseq_, bid = BIDX();
  for (int kk = (bid < nmeta ? -1 : 0); ; ++kk) {
    const int it = kk < 0 ? 1024 + bid : bid + kk * (int)gridDim.x;
    if (kk >= 0 && it >= 1024) break;
    int tid_ = tid0; asm volatile("" : "+v"(tid_));
    const int tid = tid_, wid = tid >> 6, lane = tid & 63, d = tid & 127, ig = tid >> 7;
    const int ch = it >> 2, hd = it & 3;
    const bool ismeta = ch >= 256;
    const int row0 = ismeta ? NREAL + 256 * (ch - 256) : ch * 64;
    unsigned qk[16];
    { const unsigned voff = (unsigned)(ig * 16 * 2048 + d) * 2u;
      const char* ub = (const char*)(b2 + (size_t)row0 * 2048 + hd * 128);
#pragma unroll
      for (int ii = 0; ii < 16; ++ii) { const char* ubi = ub + ii * 4096;
        qk[ii] = (unsigned)*(const bf16_t*)(ubi + voff) | ((unsigned)*(const bf16_t*)(ubi + 1024 + voff) << 16); } }
    {
#pragma unroll
      for (int q = 0; q < 4; ++q) { const int c = tid + q * NTHR, i = c >> 5, c8 = (c & 31) * 8;
        *(u32x4*)(vt + i * 264 + c8) = *(const u32x4*)(b2 + (size_t)(row0 + i) * 2048 + 1024 + hd * 256 + c8); }
      for (int e = tid; e < 64 * 32; e += NTHR) { const int i = e >> 5, c = e & 31; af[e] = bf2f(b4[(size_t)(row0 + i) * 256 + 64 + c]); }
    }
    __syncthreads();
    { bf16_t* dst = (bf16_t*)(gp + GP_VT) + ((size_t)ch * 4 + hd) * 256 * 64;
#pragma unroll
      for (int q = 0; q < 4; ++q) { const int i8 = (tid & 7) * 8, c = (tid >> 3) + 64 * q; bf16x8 w;
#pragma unroll
        for (int e = 0; e < 8; ++e) w[e] = (short)vt[(i8 + e) * 264 + c];
        *(bf16x8*)(dst + c * 64 + i8) = w; } }
    { float wf[16], wb[16];
#pragma unroll
      for (int k = 0; k < 16; ++k) { wf[k] = smg[S_WAF + k * 512 + hd * 128 + d]; wb[k] = smg[S_WAB + k * 512 + hd * 128 + d]; }
      const float bfv = smg[S_BAF + hd * 128 + d], bbv = smg[S_BAB + hd * 128 + d];
      float tfl = 0.f, tbl = 0.f;
#pragma unroll 2
      for (int ii = 0; ii < 16; ++ii) { const int i = ig * 16 + ii; float sf = bfv, sb = bbv; const float* a = af + i * 32;
#pragma unroll
        for (int k = 0; k < 16; ++k) { sf += a[k] * wf[k]; sb += a[16 + k] * wb[k]; }
        float lf = (fminf(sf, 0.f) - __logf(1.f + __expf(-fabsf(sf)))) * (1.f / 16.f), lb = (fminf(sb, 0.f) - __logf(1.f + __expf(-fabsf(sb)))) * (1.f / 16.f);
        if (ismeta && i >= 16) { lf = 0.f; lb = 0.f; }
        lgF[i * LGP + d] = lf; lgB[i * LGP + d] = lb; tfl += lf; tbl += lb; }
      tot[ig * 128 + d] = tfl; tot[512 + ig * 128 + d] = tbl;
    }
    __syncthreads();
    { const float t0 = tot[d], t1 = tot[128 + d], t2 = tot[256 + d], t3 = tot[384 + d];
      const float u0 = tot[512 + d], u1 = tot[640 + d], u2 = tot[768 + d], u3 = tot[896 + d];
      const float blF = (t0 + t1) + (t2 + t3), brF = t0 + t1, blB = (u0 + u1) + (u2 + u3), brB = u2 + u3;
      const float offF = ig == 0 ? 0.f : ig == 1 ? t0 : ig == 2 ? t0 + t1 : (t0 + t1) + t2;
      const float offB = ig == 3 ? 0.f : ig == 2 ? u3 : ig == 1 ? u2 + u3 : (u1 + u2) + u3;
      const float myB = ig == 0 ? u0 : ig == 1 ? u1 : ig == 2 ? u2 : u3;
      if (ig == 0) { float* dc = (float*)(gp + GP_DC) + ((size_t)ch * 4 + hd) * 2 * 128; dc[d] = __expf(blF); dc[128 + d] = __expf(blB); }
      bf16_t* qtF = (bf16_t*)(gp + GP_QT) + (((size_t)ch * 4 + hd) * 2 + 0) * 64 * 128; bf16_t* qtB = qtF + 64 * 128;
      float runF = offF, runB = offB + myB;
#pragma unroll
      for (int ii = 0; ii < 16; ++ii) { const int i = ig * 16 + ii;
        const float q = bflo(qk[ii]) * 0.08838834764831845f, k = bfhi(qk[ii]);
        const float lf = lgF[i * LGP + d], lb = lgB[i * LGP + d];
        runF += lf; const float bcF = runF, bcB = runB; runB -= lb;
        qtF[i * 128 + d] = f2bf(q * __expf(bcF)); qtB[i * 128 + d] = f2bf(q * __expf(bcB));
        qhF[i * 128 + d] = f2bf(q * __expf(bcF - brF)); khF[i * 128 + d] = f2bf(k * __expf(brF - bcF));
        qhB[i * 128 + d] = f2bf(q * __expf(bcB - brB)); khB[i * 128 + d] = f2bf(k * __expf(brB - bcB));
        lgF[i * LGP + d] = k * __expf(blF - bcF); lgB[i * LGP + d] = k * __expf(blB - bcB);
        if ((ii & 1) == 1) asm volatile("" ::: "memory"); }
    }
    __syncthreads();
    { bf16_t* ktF = (bf16_t*)(gp + GP_KT) + (((size_t)ch * 4 + hd) * 2 + 0) * 128 * 64; bf16_t* ktB = ktF + 128 * 64;
#pragma unroll
      for (int q = 0; q < 2; ++q) { const int i8 = (tid & 7) * 8, dd = (tid >> 3) + 64 * q; float f[8];
#pragma unroll
        for (int e = 0; e < 8; ++e) f[e] = lgF[(i8 + e) * LGP + dd];
        *(u32x4*)(ktF + dd * 64 + i8) = pack8(f);
#pragma unroll
        for (int e = 0; e < 8; ++e) f[e] = lgB[(i8 + e) * LGP + dd];
        *(u32x4*)(ktB + dd * 64 + i8) = pack8(f); }
      const int dir = wid >> 2, qi = (wid >> 1) & 1, qj = wid & 1, r32 = lane & 31, hi = lane >> 5;
      const bf16_t* qh = dir ? qhB : qhF; const bf16_t* kh = dir ? khB : khF;
      f32x16 acc = {};
#pragma unroll
      for (int ks = 0; ks < 8; ++ks) {
        const bf16x8 a = *(const bf16x8*)(qh + (32 * qi + r32) * 128 + ks * 16 + hi * 8);
        const bf16x8 b = *(const bf16x8*)(kh + (32 * qj + r32) * 128 + ks * 16 + hi * 8);
        acc = __builtin_amdgcn_mfma_f32_32x32x16_bf16(a, b, acc, 0, 0, 0); }
      bf16_t* am = (bf16_t*)(gp + GP_AM) + (((size_t)ch * 4 + hd) * 2 + dir) * 64 * 64;
#pragma unroll
      for (int r = 0; r < 16; ++r) { const int i = 32 * qi + crow(r, hi), j = 32 * qj + r32;
        const bool keep = dir ? (i <= j) : (i >= j);
        am[i * 64 + j] = f2bf(keep ? acc[r] : 0.f); }
    }
    __syncthreads();
  }
}

constexpr int GS_QT = 0, GS_KT = 16384, GS_AM = 32768, GS_DC = 40960, GS_STAGE = 41472;
#define GS_WAIT(n) asm volatile("s_waitcnt vmcnt(" #n ")" ::: "memory")
template <bool FINAL>
LPHASE void phase_gla_scan(char* ws_, int nseq_, char* ldsg, LAS unsigned char* lds) {
  const int tid = TIDX(), wid = __builtin_amdgcn_readfirstlane(tid >> 6), lane = tid & 63, fr = lane & 15, fq = lane >> 4;
  char* wsp = opaque(ws_);
  char* gp = wsp + O_GP;
  const int Ls = nseq_ == 2 ? 8192 : 16384;
  const int CS = Ls / 64, nls = CS / 16;
  unsigned oq[2], ok[2], oa;
#pragma unroll
  for (int j = 0; j < 2; ++j) { const int pq = 128 * wid + 64 * j + lane, rq = pq >> 4, cq = (pq & 15) ^ (rq & 15); oq[j] = (unsigned)(rq * 256 + cq * 16);
    const int pk = 128 * wid + 64 * j + lane, rk = pk >> 3, ck = (pk & 7) ^ (rk & 7); ok[j] = (unsigned)(rk * 128 + ck * 16); }
  { const int pa = 64 * wid + lane, ra = pa >> 3, ca = (pa & 7) ^ (ra & 7); oa = (unsigned)(ra * 128 + ca * 16); }
  for (int it = BIDX(); it < 256; it += gridDim.x) {
    const int half = it & 1, dir = (it >> 1) & 1, hd = (it >> 2) & 3, sg = it >> 4;
    const int s = sg / nls, ls = sg % nls;
    const int colb = half * 128 + wid * 16;
    float* Ub = (float*)(gp + GP_U); float* Db = (float*)(gp + GP_D);
    const bool has_meta = (dir == 0 && ls == 0);
    const int nsteps = 16 + (has_meta ? 1 : 0);
    auto chunk_of = [&](int st) -> int {
      if (dir == 0) { if (has_meta) return st == 0 ? 256 + s : s * CS + (st - 1); return s * CS + ls * 16 + st; }
      return s * CS + ls * 16 + (15 - st); };
    bf16x8 v0a, v0b, v1a, v1b, v2a, v2b;
#define GS_ISSUE(st_, sgi_, VA, VB) do { const int _st = (st_) < nsteps ? (st_) : nsteps - 1; const int _ch = chunk_of(_st); const size_t _cb = ((size_t)_ch * 4 + hd) * 2 + dir; \
      const unsigned _lb = (unsigned)(sgi_) * GS_STAGE; \
      const char* _kt = gp + GP_KT + _cb * 16384; \
      __builtin_amdgcn_global_load_lds((const unsigned*)(_kt + ok[0]), (LAS unsigned*)(lds + _lb + GS_KT + (128 * wid) * 16), 16, 0, 0); \
      __builtin_amdgcn_global_load_lds((const unsigned*)(_kt + ok[1]), (LAS unsigned*)(lds + _lb + GS_KT + (128 * wid + 64) * 16), 16, 0, 0); \
      if (FINAL) { const char* _qt = gp + GP_QT + _cb * 16384; const char* _am = gp + GP_AM + _cb * 8192; \
        __builtin_amdgcn_global_load_lds((const unsigned*)(_qt + oq[0]), (LAS unsigned*)(lds + _lb + GS_QT + (128 * wid) * 16), 16, 0, 0); \
        __builtin_amdgcn_global_load_lds((const unsigned*)(_qt + oq[1]), (LAS unsigned*)(lds + _lb + GS_QT + (128 * wid + 64) * 16), 16, 0, 0); \
        __builtin_amdgcn_global_load_lds((const unsigned*)(_am + oa), (LAS unsigned*)(lds + _lb + GS_AM + (64 * wid) * 16), 16, 0, 0); } \
      if (lane < 4) __builtin_amdgcn_global_load_lds((const unsigned*)(gp + GP_DC + _cb * 512 + (4 * wid + lane) * 16), (LAS unsigned*)(lds + _lb + GS_DC + (4 * wid) * 16), 16, 0, 0); \
      const bf16_t* _vt = (const bf16_t*)(gp + GP_VT) + ((size_t)_ch * 4 + hd) * 256 * 64 + (size_t)(colb + fr) * 64; \
      VA = *(const bf16x8*)(_vt + fq * 8); VB = *(const bf16x8*)(_vt + 32 + fq * 8); } while (0)
    GS_ISSUE(0, 0, v0a, v0b);
    GS_ISSUE(1, 1, v1a, v1b);
    f32x4 S[8];
#pragma unroll
    for (int t = 0; t < 8; ++t) S[t] = (f32x4){0.f, 0.f, 0.f, 0.f};
    f32x4 Dc[8];
#pragma unroll
    for (int t = 0; t < 8; ++t) Dc[t] = (f32x4){1.f, 1.f, 1.f, 1.f};
    if (FINAL) {
      const int np = dir ? (nls - 1 - ls) : ls;
      f32x4 W[8];
#pragma unroll
      for (int t = 0; t < 8; ++t) W[t] = (f32x4){1.f, 1.f, 1.f, 1.f};
#pragma unroll 2
      for (int q = 0; q < np; ++q) { const int ps = dir ? (ls + 1 + q) : (ls - 1 - q); const int psg = s * nls + ps;
        const f32x4* U = (const f32x4*)(Ub + (((size_t)psg * 4 + hd) * 2 + dir) * 128 * 256) + ((size_t)(colb >> 4) * 8) * 64 + lane; const float* D = Db + (((size_t)psg * 4 + hd) * 2 + dir) * 128;
#pragma unroll
        for (int t = 0; t < 8; ++t) { const f32x4 dv = *(const f32x4*)(D + 16 * t + 4 * fq); const f32x4 uv = U[t * 64];
          S[t] += W[t] * uv; W[t] *= dv; } }
    }
    for (int st = 0; st < nsteps; ++st) {
      const bool metastep = has_meta && st == 0;
      const bool prev_stores = FINAL && st > 0 && !(has_meta && st == 1);
      if (FINAL) { if (prev_stores) GS_WAIT(24); else GS_WAIT(8); } else GS_WAIT(5);
      asm volatile("s_waitcnt lgkmcnt(0)" ::: "memory"); __builtin_amdgcn_s_barrier(); asm volatile("" ::: "memory");
      const int sgi2 = (st + 2) % 3;
      GS_ISSUE(st + 2, sgi2, v2a, v2b);
      const char* L = ldsg + (st % 3) * GS_STAGE;
      if (FINAL && !metastep) {
        const int ch = chunk_of(st);
        bf16x8 sB[4];
#pragma unroll
        for (int ks = 0; ks < 4; ++ks) { u32x4 w; w.x = cvtpk(S[2 * ks][0], S[2 * ks][1]); w.y = cvtpk(S[2 * ks][2], S[2 * ks][3]);
          w.z = cvtpk(S[2 * ks + 1][0], S[2 * ks + 1][1]); w.w = cvtpk(S[2 * ks + 1][2], S[2 * ks + 1][3]); sB[ks] = *reinterpret_cast<bf16x8*>(&w); }
        bf16_t* od = (bf16_t*)(wsp + O_OFB) + (size_t)dir * NREAL * 1024 + (size_t)(ch * 64) * 1024 + hd * 256 + colb + fr;
#pragma unroll
        for (int mt = 0; mt < 4; ++mt) {
          f32x4 o = (f32x4){0.f, 0.f, 0.f, 0.f};
          const char* ar = L + GS_AM + (16 * mt + fr) * 128;
          o = __builtin_amdgcn_mfma_f32_16x16x32_bf16(*(const bf16x8*)(ar + (((fq) ^ (fr & 7)) << 4)), v0a, o, 0, 0, 0);
          o = __builtin_amdgcn_mfma_f32_16x16x32_bf16(*(const bf16x8*)(ar + (((4 + fq) ^ (fr & 7)) << 4)), v0b, o, 0, 0, 0);
          const char* qrw = L + GS_QT + (16 * mt + fr) * 256 + (fq & 1) * 8;
#pragma unroll
          for (int ks = 0; ks < 4; ++ks) { const s16x4 lo = *(const s16x4*)(qrw + (((4 * ks + (fq >> 1)) ^ fr) << 4)), hi4 = *(const s16x4*)(qrw + (((4 * ks + 2 + (fq >> 1)) ^ fr) << 4));
            const bf16x8 a = (bf16x8){lo[0], lo[1], lo[2], lo[3], hi4[0], hi4[1], hi4[2], hi4[3]};
            o = __builtin_amdgcn_mfma_f32_16x16x32_bf16(a, sB[ks], o, 0, 0, 0); }
#pragma unroll
          for (int j = 0; j < 4; ++j) od[(size_t)(16 * mt + 4 * fq + j) * 1024] = f2bf(o[j]);
        }
      }
#pragma unroll
      for (int t = 0; t < 8; ++t) { const f32x4 dv = *(const f32x4*)(L + GS_DC + (16 * t + 4 * fq) * 4);
        S[t] *= dv; if (!FINAL) Dc[t] *= dv;
        const char* kr = L + GS_KT + (16 * t + fr) * 128;
        S[t] = __builtin_amdgcn_mfma_f32_16x16x32_bf16(*(const bf16x8*)(kr + (((fq) ^ (fr & 7)) << 4)), v0a, S[t], 0, 0, 0);
        S[t] = __builtin_amdgcn_mfma_f32_16x16x32_bf16(*(const bf16x8*)(kr + (((4 + fq) ^ (fr & 7)) << 4)), v0b, S[t], 0, 0, 0); }
      v0a = v1a; v0b = v1b; v1a = v2a; v1b = v2b;
    }
    GS_WAIT(0); __syncthreads();
    if (!FINAL) {
      float* U = Ub + (((size_t)sg * 4 + hd) * 2 + dir) * 128 * 256; float* D = Db + (((size_t)sg * 4 + hd) * 2 + dir) * 128;
#pragma unroll
      for (int t = 0; t < 8; ++t) {
        ((f32x4*)U)[((size_t)(colb >> 4) * 8 + t) * 64 + lane] = S[t];
        if (half == 0 && wid == 0 && fr == 0) *(f32x4*)(D + 16 * t + 4 * fq) = Dc[t]; }
    }
#undef GS_ISSUE
  }
}

#ifndef NO_GEMM
#define GEMMCALL(l,g,e) gemm_phase(l,g,e)
#else
#define GEMMCALL(l,g,e) (void)0
#endif
#define LA p.ws, G.x, G.out, p.meta, G.nseq

#define XB_TMO      128
#define XB_XCNT(j)  (256  + 64 * (j))
#define XB_XSUB(j)  (1280 + 64 * (j))
#define XB_XGEN(j)  (2304 + 64 * (j))
#define XB_TOP      3328
#define XB_TOPGEN   3392
#define XCD_BAR_WORDS 3456
#define XB_SPIN_CAP (1u << 22)
__device__ __forceinline__ unsigned xb_ld(unsigned* p)              { return __hip_atomic_load(p, __ATOMIC_RELAXED, __HIP_MEMORY_SCOPE_AGENT); }
__device__ __forceinline__ unsigned xb_add(unsigned* p, unsigned v) { return __hip_atomic_fetch_add(p, v, __ATOMIC_RELAXED, __HIP_MEMORY_SCOPE_AGENT); }
__device__ __forceinline__ unsigned xb_xcc_id() { return (unsigned)__builtin_amdgcn_s_getreg((3 << 11) | 20) & 0xFu; }
#define XB_SPIN(cond, bar) do { unsigned _sp = 0; while (cond) { __builtin_amdgcn_s_sleep(1); \
    if ((++_sp & 255u) == 0u) { if (xb_ld(&(bar)[XB_TMO])) break; if (_sp > XB_SPIN_CAP) { atomicAdd(&(bar)[XB_TMO], 1u); break; } } } } while (0)
struct XcdBarrier { unsigned* bar; unsigned x; volatile LAS unsigned* st; };
__device__ __forceinline__ XcdBarrier xcd_barrier_post(unsigned* bar, volatile LAS unsigned* st) {
  XcdBarrier b; b.bar = bar; b.x = xb_xcc_id(); b.st = st;
  if (threadIdx.x == 0) (void)xb_add(&bar[XB_XCNT(b.x)], 1u);
  return b;
}
__device__ __forceinline__ void xcd_barrier_complete(unsigned* bar, unsigned x, unsigned& nloc, unsigned& nx) {
  const unsigned G = gridDim.x * gridDim.y * gridDim.z;
  unsigned sum, cnt, mine, sp = 0u;
  for (;;) {
    sum = 0u; cnt = 0u; mine = 0u;
#pragma unroll
    for (unsigned j = 0; j < 16; ++j) { const unsigned c = xb_ld(&bar[XB_XCNT(j)]); sum += c; cnt += (c > 0u) ? 1u : 0u; mine = (j == x) ? c : mine; }
    if (sum == G) break;
    __builtin_amdgcn_s_sleep(1);
    if ((++sp & 255u) == 0u) { if (xb_ld(&bar[XB_TMO])) break; if (sp > XB_SPIN_CAP) { atomicAdd(&bar[XB_TMO], 1u); break; } }
  }
  nloc = mine > 0u ? mine : 1u; nx = cnt > 0u ? cnt : 1u;
}
__device__ __forceinline__ void xcd_barrier(const XcdBarrier& b) {
  asm volatile("s_waitcnt vmcnt(0)" ::: "memory");
  __syncthreads();
  if (threadIdx.x == 0) {
    unsigned* bar = b.bar;
    __builtin_amdgcn_s_waitcnt(0);
    unsigned nloc = b.st[0], nx = b.st[1];
    if (nloc == 0u) { xcd_barrier_complete(bar, b.x, nloc, nx); b.st[0] = nloc; b.st[1] = nx; }
    const unsigned old = xb_add(&bar[XB_XSUB(b.x)], 1u);
    const unsigned gen = old / nloc;
    if (old + 1u == (gen + 1u) * nloc) {
      __builtin_amdgcn_fence(__ATOMIC_RELEASE, "agent");
      asm volatile("s_waitcnt vmcnt(0)" ::: "memory");
      const unsigned og = xb_add(&bar[XB_TOP], 1u);
      const unsigned tg = og / nx;
      if (og + 1u == (tg + 1u) * nx) xb_add(&bar[XB_TOPGEN], 1u);
      else XB_SPIN(xb_ld(&bar[XB_TOPGEN]) == tg, bar);
      __builtin_amdgcn_fence(__ATOMIC_ACQUIRE, "agent");
      xb_add(&bar[XB_XGEN(b.x)], 1u);
      asm volatile("s_waitcnt vmcnt(0)" ::: "memory");
    } else {
      XB_SPIN(xb_ld(&bar[XB_XGEN(b.x)]) == gen, bar);
      __builtin_amdgcn_fence(__ATOMIC_ACQUIRE, "agent");
      asm volatile("s_waitcnt vmcnt(0)" ::: "memory");
    }
  }
  __syncthreads();
}
struct EpiGen { int kind, kind2; bf16_t *b0, *b1, *b2, *b3; float* f0; const float* cf0;
  __device__ __forceinline__ void st2(int w, int r, int c, f32x4 v0, f32x4 v1) const {
    switch (w ? kind2 : kind) {
      case 0: { EpiInproj E{b0, b1, b2, b3}; E.st(r, c, v0, v1); } break;
      case 1: { EpiBf16 E{b0, 1536}; E.st(r, c, v0, v1); } break;
      case 2: { EpiKV E{b0, b1}; E.st(r, c, v0, v1); } break;
      case 3: { EpiGateA E{b0, b2}; E.st(r, c, v0, v1); } break;
      case 4: { EpiGateB E{b0, b2, b1}; E.st(r, c, v0, v1); } break;
      case 5: { EpiX1 E{cf0, f0}; E.st(r, c, v0, v1); } break;
      case 6: { EpiFfnUp E{b0}; E.st(r, c, v0, v1); } break;
      default: { EpiFfnDown E{f0}; E.st(r, c, v0, v1); } break;
    }
  } };

constexpr int NSTEP_G = 17;
__global__ void __launch_bounds__(NTHR, 2) mega(Params p) {
  extern __shared__ __attribute__((aligned(16))) unsigned char lds_raw[];
  cg::grid_group grid = cg::this_grid();
  LAS unsigned char* lds = (LAS unsigned char*)lds_raw;
  char* ldsg = (char*)lds_raw;
  if (threadIdx.x < 4) ((LAS unsigned*)(lds + LDS_BYTES - 16))[threadIdx.x] = 0u;
  __syncthreads();
  const XcdBarrier xb = xcd_barrier_post((unsigned*)(p.ws + O_BAR), (volatile LAS unsigned*)(lds + LDS_BYTES - 16));
  phase_weights(p);
  grid.sync();
#ifdef PROBE_AT
  constexpr int NSTP = NSTEP_G + 1;
#else
  constexpr int NSTP = NSTEP_G;
#endif
#pragma unroll 1
  for (int step = 0; step < 3 * NSTP; ++step) {
    const int g = step / NSTP; int ph = step % NSTP;
#ifdef PROBE_AT
    ph -= (ph > PROBE_AT) ? 1 : 0;
#endif
    char* ws = opaque(p.ws);
    const Grp G = make_grp(p, g);
    bool is_gemm = false, sync_after = true;
    Gemm gm{nullptr, nullptr, 1024, 1024, NREAL, 1024, 1024, nullptr, nullptr};
    EpiGen E{0, 0, nullptr, nullptr, nullptr, nullptr, nullptr, nullptr};
    switch (ph) {
      case 0: rows_h(LA); break;
      case 1: is_gemm = true; gm = Gemm{(const bf16_t*)(ws + O_H), (const bf16_t*)(ws + O_WIN), 1024, 1024, G.RG, NIN, 1024, nullptr, nullptr};
              E.kind = 0; E.b0 = (bf16_t*)(ws + O_B1); E.b1 = (bf16_t*)(ws + O_B2); E.b2 = (bf16_t*)(ws + O_G3); E.b3 = (bf16_t*)(ws + O_B4); break;
      case 2: rows_cnorm(LA); sync_after = false; break;
#ifndef NO_PREP
      case 3: phase_gla_prep(p.ws, G.x, G.out, p.meta, G.nseq, ldsg); break;
#endif
      case 4: is_gemm = true; sync_after = false; gm = Gemm{(const bf16_t*)(ws + O_B1), (const bf16_t*)(ws + O_WUQ), 1024, 768, G.RG, 1536, 768, nullptr, nullptr};
              E.kind = 1; E.b0 = (bf16_t*)G.out; break;
      case 5: is_gemm = true; sync_after = false; gm = Gemm{(const bf16_t*)(ws + O_B1) + 768, (const bf16_t*)(ws + O_WUKV), 1024, 256, G.RG, 2048, 256, nullptr, nullptr};
              E.kind = 2; E.b0 = (bf16_t*)(ws + O_KNR); E.b1 = (bf16_t*)(ws + O_V); break;
#ifndef NO_SCAN
      case 6: phase_gla_scan<false>(p.ws, G.nseq, ldsg, lds); break;
#endif
      case 7: rows_qk(LA); sync_after = false; break;
#ifndef NO_SCAN2
      case 8: phase_gla_scan<true>(p.ws, G.nseq, ldsg, lds); break;
#endif
      case 9: rows_ogla(LA); sync_after = false; break;
      case 10: phase_attn(p, G, ldsg, lds); break;
      case 11: is_gemm = true; gm = Gemm{(const bf16_t*)(ws + O_OMLA), (const bf16_t*)(ws + O_WOM), 1024, 1024, NREAL, 1024, 1024, (const bf16_t*)(ws + O_OGLA), (const bf16_t*)(ws + O_WOG)};
              E.kind = 3; E.kind2 = 4; E.b0 = (bf16_t*)(ws + O_G3); E.b2 = (bf16_t*)(ws + O_TMP); E.b1 = (bf16_t*)(ws + O_MIX); break;
      case 12: sync_after = false; break;
      case 13: is_gemm = true; gm = Gemm{(const bf16_t*)(ws + O_MIX), (const bf16_t*)(ws + O_WOUT), 1024, 1024, NREAL, 1024, 1024, nullptr, nullptr};
              E.kind = 5; E.cf0 = G.x; E.f0 = G.out; break;
      case 14: rows_h2(LA); break;
      case 15: is_gemm = true; gm = Gemm{(const bf16_t*)(ws + O_H2), (const bf16_t*)(ws + O_WGU), 1024, 1024, NREAL, 5632, 1024, nullptr, nullptr};
              E.kind = 6; E.b0 = (bf16_t*)(ws + O_ACT); break;
      default: is_gemm = true; gm = Gemm{(const bf16_t*)(ws + O_ACT), (const bf16_t*)(ws + O_WD), DFF, DFF, NREAL, 1024, DFF, nullptr, nullptr};
              E.kind = 7; E.f0 = G.out; break;
    }
    if (is_gemm) gemm_phase(lds, gm, E);
    if (sync_after) xcd_barrier(xb);
  }
}

extern "C" void kernel_launch(void* const* d_in, const int* in_sizes, int n_in, void* d_out, int out_size, void* d_ws, size_t ws_size, hipStream_t stream) {
  static int grid_blocks = 0;
  if (grid_blocks == 0) {
    if (n_in != 23 || ws_size < WS_END) { fprintf(stderr, "kernel_launch: unexpected inputs (n_in %d, ws %zu, need %zu)\n", n_in, ws_size, (size_t)WS_END); grid_blocks = -1; return; }
    int dev = 0, cus = 0, per_cu = 0;
    (void)hipGetDevice(&dev); (void)hipDeviceGetAttribute(&cus, hipDeviceAttributeMultiprocessorCount, dev);
    if (hipFuncSetAttribute((const void*)mega, hipFuncAttributeMaxDynamicSharedMemorySize, LDS_BYTES) != hipSuccess) { fprintf(stderr, "kernel_launch: hipFuncSetAttribute failed\n"); grid_blocks = -1; return; }
    if (hipOccupancyMaxActiveBlocksPerMultiprocessor(&per_cu, (const void*)mega, NTHR, LDS_BYTES) != hipSuccess || per_cu < 1) { fprintf(stderr, "kernel_launch: occupancy query gives %d\n", per_cu); per_cu = 1; }
    (void)hipGetLastError();
    grid_blocks = cus * per_cu;
    if (grid_blocks > 256) grid_blocks = 256;
  }
  if (grid_blocks < 0) return;
  Params p{};
  const float** pp = (const float**)&p;
  for (int i = 0; i < 23; ++i) pp[i] = (const float*)d_in[i];
  p.out = (float*)d_out; p.ws = (char*)d_ws;
  (void)hipMemsetAsync((char*)d_ws + O_BAR, 0, 3456 * 4, stream);
  void* args[] = {&p};
  hipError_t e = hipLaunchCooperativeKernel((const void*)mega, dim3(grid_blocks), dim3(NTHR), args, LDS_BYTES, stream);
  if (e != hipSuccess) fprintf(stderr, "cooperative launch failed: %s (grid %d)\n", hipGetErrorString(e), grid_blocks);
}
```

```cpp
#include <hip/hip_runtime.h>
#include <hip/hip_cooperative_groups.h>
#include <cstdio>
#include <cstdint>
namespace cg = cooperative_groups;

typedef unsigned short bf16_t;
typedef short bf16x8 __attribute__((ext_vector_type(8)));
typedef short s16x4 __attribute__((ext_vector_type(4)));
typedef float f32x4 __attribute__((ext_vector_type(4)));
typedef float f32x16 __attribute__((ext_vector_type(16)));
typedef unsigned u32x4 __attribute__((ext_vector_type(4)));
typedef unsigned u32x2 __attribute__((ext_vector_type(2)));
#define LAS __attribute__((address_space(3)))
#define SBAR() __builtin_amdgcn_sched_barrier(0)
__device__ __forceinline__ int TIDX() { int t = threadIdx.x; asm volatile("" : "+v"(t)); return t; }
__device__ __forceinline__ char* opaque(char* q) { size_t z = 0; asm volatile("" : "+s"(z)); return q + z; }
__device__ __forceinline__ int BIDX() { int b = blockIdx.x; asm volatile("" : "+s"(b)); return b; }

constexpr int DM = 1024, NREAL = 16384, RGMAX = NREAL + 512, DIN = 6240, NIN = 6400, DFF = 2816;
constexpr float EPS = 1e-6f;
constexpr int NTHR = 512;
constexpr int LDS_BYTES = 136 * 1024;

constexpr size_t al256(size_t x) { return (x + 255) / 256 * 256; }
constexpr size_t O_WIN = 0;
constexpr size_t O_WUQ = O_WIN + (size_t)NIN * 1024 * 2;
constexpr size_t O_WUKV = O_WUQ + (size_t)1536 * 768 * 2;
constexpr size_t O_WOM = O_WUKV + (size_t)2048 * 256 * 2;
constexpr size_t O_WOG = O_WOM + (size_t)1024 * 1024 * 2;
constexpr size_t O_WOUT = O_WOG + (size_t)1024 * 1024 * 2;
constexpr size_t O_WGU = O_WOUT + (size_t)1024 * 1024 * 2;
constexpr size_t O_WD = O_WGU + (size_t)5632 * 1024 * 2;
constexpr size_t O_G3 = O_WD + (size_t)1024 * DFF * 2;
constexpr size_t O_GP = O_G3 + (size_t)NREAL * 3072 * 2;
constexpr int NCHK = 258;
constexpr size_t GP_QT = 0;
constexpr size_t GP_KT = GP_QT + (size_t)NCHK * 4 * 2 * 64 * 128 * 2;
constexpr size_t GP_AM = GP_KT + (size_t)NCHK * 4 * 2 * 64 * 128 * 2;
constexpr size_t GP_VT = GP_AM + (size_t)NCHK * 4 * 2 * 64 * 64 * 2;
constexpr size_t GP_DC = GP_VT + (size_t)NCHK * 4 * 256 * 64 * 2;
constexpr size_t GP_U = GP_DC + (size_t)NCHK * 4 * 2 * 128 * 4;
constexpr size_t GP_D = GP_U + (size_t)16 * 4 * 2 * 128 * 256 * 4;
constexpr size_t GP_END = al256(GP_D + (size_t)16 * 4 * 2 * 128 * 4);
constexpr size_t O_V = O_GP + GP_END;
constexpr size_t O_QK = O_V + (size_t)RGMAX * 1024 * 2;
constexpr size_t O_OFB = O_QK + (size_t)RGMAX * 3072 * 2;
constexpr size_t O_OMLA = O_OFB + (size_t)NREAL * 2048 * 2;
constexpr size_t O_B4 = O_OMLA + (size_t)RGMAX * 1024 * 2;
constexpr size_t O_SMALL = O_B4 + (size_t)RGMAX * 256 * 2;
constexpr int S_ATTN = 0, S_QA = 1024, S_KVA = 1792, S_QN = 2048, S_KN = 2240, S_WAF = 2432, S_BAF = S_WAF + 8192, S_WAB = S_BAF + 512, S_BAB = S_WAB + 8192, S_GON = S_BAB + 512, S_FFN = S_GON + 256, S_END = S_FFN + 1024;
constexpr size_t O_BAR = al256(O_SMALL + (size_t)S_END * 4);
constexpr size_t WS_END = O_BAR + 3456 * 4;
constexpr size_t O_H = O_QK;
constexpr size_t O_B1 = O_QK + (size_t)RGMAX * 1024 * 2;
constexpr size_t O_B2 = O_OFB;
constexpr size_t O_KNR = O_OMLA;
constexpr size_t O_OGLA = O_GP + (size_t)NREAL * 1024 * 4;
constexpr size_t O_MIX = O_QK + (size_t)NREAL * 1024 * 2;
constexpr size_t O_H2 = O_QK + (size_t)NREAL * 2048 * 2;
constexpr size_t O_TMP = O_GP;
constexpr size_t O_ACT = O_GP;
static_assert(O_KNR + (size_t)RGMAX * 1024 * 2 <= O_B4 && (size_t)RGMAX * 1536 * 2 <= (size_t)NREAL * 1024 * 4, "overlay");
static_assert((size_t)RGMAX * 2048 * 2 <= (size_t)NREAL * 2048 * 2 + (size_t)RGMAX * 1024 * 2, "overlay b2");
static_assert((size_t)NREAL * 1024 * 4 + (size_t)NREAL * 1024 * 2 <= GP_END, "overlay ogla");
static_assert((size_t)NREAL * DFF * 2 <= GP_END && (size_t)NREAL * 1024 * 4 <= GP_END, "overlay act");
static_assert(WS_END <= (size_t)512 * 1024 * 1024, "workspace");

struct Params {
  const float *x_prompt, *x_sample, *meta, *attn_norm, *w_in, *q_a_norm, *w_uq, *kv_a_norm, *w_ukv, *q_norm, *k_norm, *w_o_mla,
      *w_a2_f, *b_a2_f, *w_a2_b, *b_a2_b, *gla_o_norm, *w_o_gla, *w_out, *ffn_norm, *w_gate, *w_up, *w_down;
  float* out; char* ws;
};

typedef __bf16 bf2_t __attribute__((ext_vector_type(2)));
typedef float f32x2_t __attribute__((ext_vector_type(2)));
__device__ __forceinline__ unsigned cvtpk(float lo, float hi) { f32x2_t v = {lo, hi}; bf2_t b = __builtin_convertvector(v, bf2_t); return *reinterpret_cast<unsigned*>(&b); }
__device__ __forceinline__ bf16_t f2bf(float f) { return (bf16_t)(cvtpk(f, 0.f) & 0xffffu); }
__device__ __forceinline__ float bf2f(bf16_t b) { return __uint_as_float(((unsigned)b) << 16); }
__device__ __forceinline__ float bflo(unsigned w) { return __uint_as_float(w << 16); }
__device__ __forceinline__ float bfhi(unsigned w) { return __uint_as_float(w & 0xffff0000u); }
__device__ __forceinline__ float wave_sum(float v) { for (int o = 32; o >= 1; o >>= 1) v += __shfl_xor(v, o); return v; }
__device__ __forceinline__ float sigmoidf_(float x) { return 1.f / (1.f + __expf(-x)); }
__device__ __forceinline__ void unpack8(u32x4 w, float* f) { f[0] = bflo(w.x); f[1] = bfhi(w.x); f[2] = bflo(w.y); f[3] = bfhi(w.y); f[4] = bflo(w.z); f[5] = bfhi(w.z); f[6] = bflo(w.w); f[7] = bfhi(w.w); }
__device__ __forceinline__ u32x4 pack8(const float* f) { u32x4 w; w.x = cvtpk(f[0], f[1]); w.y = cvtpk(f[2], f[3]); w.z = cvtpk(f[4], f[5]); w.w = cvtpk(f[6], f[7]); return w; }

template <class ColPtr>
__device__ void transpose_w(int K, long ld, bf16_t* dst, int Ndst, ColPtr colptr) {
  const int kb8 = K / 8; const long total = (long)(Ndst / 64) * kb8 * 64;
  for (long i = (long)BIDX() * NTHR + TIDX(); i < total; i += (long)gridDim.x * NTHR) {
    const int nl = (int)(i & 63); const long rest = i >> 6; const int kb = (int)(rest % kb8); const int nb = (int)(rest / kb8);
    const int n = nb * 64 + nl; const float* p = colptr(n);
    float v[8];
#pragma unroll
    for (int e = 0; e < 8; ++e) v[e] = p ? p[(long)(kb * 8 + e) * ld] : 0.f;
    *(u32x4*)(dst + (long)n * K + kb * 8) = pack8(v);
  }
}
__device__ void phase_weights(const Params& p) {
  char* ws = p.ws;
  { float* sm = (float*)(ws + O_SMALL); const int gi = BIDX() * NTHR + TIDX(), gs = gridDim.x * NTHR;
    for (int i = gi; i < 1024; i += gs) { sm[S_ATTN + i] = p.attn_norm[i]; sm[S_FFN + i] = p.ffn_norm[i]; }
    for (int i = gi; i < 768; i += gs) sm[S_QA + i] = p.q_a_norm[i];
    for (int i = gi; i < 256; i += gs) { sm[S_KVA + i] = p.kv_a_norm[i]; sm[S_GON + i] = p.gla_o_norm[i]; }
    for (int i = gi; i < 192; i += gs) { sm[S_QN + i] = p.q_norm[i]; sm[S_KN + i] = p.k_norm[i]; }
    for (int i = gi; i < 8192; i += gs) { sm[S_WAF + i] = p.w_a2_f[i]; sm[S_WAB + i] = p.w_a2_b[i]; }
    for (int i = gi; i < 512; i += gs) { sm[S_BAF + i] = p.b_a2_f[i]; sm[S_BAB + i] = p.b_a2_b[i]; } }
  { const float* w = p.w_in;
    transpose_w(1024, DIN, (bf16_t*)(ws + O_WIN), NIN, [=](int n) -> const float* {
      int o;
      if (n < 1024) o = n;
      else if (n < 2048) o = 1088 + (n - 1024);
      else if (n < 3072) o = 2112 + (n - 2048);
      else if (n < 4096) o = 3136 + (n - 3072);
      else if (n < 6144) o = 4192 + (n - 4096);
      else if (n < 6208) o = 1024 + (n - 6144);
      else if (n < 6240) o = 4160 + (n - 6208);
      else return nullptr;
      return w + o; }); }
  { const float* w = p.w_uq; transpose_w(768, 1536, (bf16_t*)(ws + O_WUQ), 1536, [=](int n) -> const float* { return w + n; }); }
  { const float* w = p.w_ukv; transpose_w(256, 2048, (bf16_t*)(ws + O_WUKV), 2048, [=](int n) -> const float* {
      return n < 1024 ? w + (n >> 7) * 256 + (n & 127) : w + ((n - 1024) >> 7) * 256 + 128 + (n & 127); }); }
  { const float* w = p.w_o_mla; transpose_w(1024, 1024, (bf16_t*)(ws + O_WOM), 1024, [=](int n) -> const float* { return w + n; }); }
  { const float* w = p.w_o_gla; transpose_w(1024, 1024, (bf16_t*)(ws + O_WOG), 1024, [=](int n) -> const float* { return w + n; }); }
  { const float* w = p.w_out; transpose_w(1024, 1024, (bf16_t*)(ws + O_WOUT), 1024, [=](int n) -> const float* { return w + n; }); }
  { const float* wg = p.w_gate; const float* wu = p.w_up;
    transpose_w(1024, DFF, (bf16_t*)(ws + O_WGU), 5632, [=](int n) -> const float* {
      const int q = n >> 3, i = n & 7; return i < 4 ? wg + q * 4 + i : wu + q * 4 + (i - 4); }); }
  { const float* w = p.w_down; transpose_w(DFF, 1024, (bf16_t*)(ws + O_WD), 1024, [=](int n) -> const float* { return w + n; }); }
}

struct Grp { const float* x; float* out; int nseq, Ls, RG; };
__device__ __forceinline__ Grp make_grp(const Params& p, int g) {
  Grp G; if (g == 0) { G.x = p.x_prompt; G.out = p.out; G.nseq = 2; G.Ls = 8192; }
  else { G.x = p.x_sample + (size_t)(g - 1) * NREAL * DM; G.out = p.out + (size_t)g * NREAL * DM; G.nseq = 1; G.Ls = 16384; }
  G.RG = NREAL + 256 * G.nseq; return G;
}

struct LArgs { char* ws; const float* x; float* out; const float* meta; int nseq; };
#define LPHASE __device__
LPHASE void rows_h(char* ws_, const float* x_, float* out_, const float* meta_, int nseq_) { struct { char* ws; const float* meta; } p; p.ws = ws_; p.meta = meta_; Grp G; G.x = x_; G.out = out_; G.nseq = nseq_; G.Ls = nseq_ == 2 ? 8192 : 16384; G.RG = NREAL + 256 * nseq_;
  const int tix = TIDX(), lane = tix & 63, gw = BIDX() * 8 + (tix >> 6), nw = gridDim.x * 8;
  bf16_t* h = (bf16_t*)(p.ws + O_H);
  for (int r = gw; r < G.RG; r += nw) {
    const float* xr = nullptr;
    if (r < NREAL) xr = G.x + (size_t)r * DM; else { const int i = (r - NREAL) & 255; if (i < 16) xr = p.meta + i * DM; }
    bf16_t* hr = h + (size_t)r * DM;
    if (!xr) {
#pragma unroll
      for (int q = 0; q < 4; ++q) *(u32x2*)(hr + q * 256 + lane * 4) = (u32x2){0u, 0u};
      continue; }
    f32x4 v[4]; float ss = 0.f;
#pragma unroll
    for (int q = 0; q < 4; ++q) { v[q] = *(const f32x4*)(xr + q * 256 + lane * 4); ss += v[q][0] * v[q][0] + v[q][1] * v[q][1] + v[q][2] * v[q][2] + v[q][3] * v[q][3]; }
    ss = wave_sum(ss); const float rs = rsqrtf(ss * (1.f / DM) + EPS);
#pragma unroll
    for (int q = 0; q < 4; ++q) { const f32x4 g = *(const f32x4*)((const float*)(p.ws + O_SMALL) + S_ATTN + q * 256 + lane * 4);
      u32x2 w; w.x = cvtpk(v[q][0] * rs * g[0], v[q][1] * rs * g[1]); w.y = cvtpk(v[q][2] * rs * g[2], v[q][3] * rs * g[3]);
      *(u32x2*)(hr + q * 256 + lane * 4) = w; }
  }
}
LPHASE void rows_h2(char* ws_, const float* x_, float* out_, const float* meta_, int nseq_) { struct { char* ws; const float* meta; } p; p.ws = ws_; p.meta = meta_; Grp G; G.x = x_; G.out = out_; G.nseq = nseq_; G.Ls = nseq_ == 2 ? 8192 : 16384; G.RG = NREAL + 256 * nseq_;
  const int tix = TIDX(), lane = tix & 63, gw = BIDX() * 8 + (tix >> 6), nw = gridDim.x * 8;
  bf16_t* h = (bf16_t*)(p.ws + O_H2);
  for (int r = gw; r < NREAL; r += nw) {
    const float* xr = G.out + (size_t)r * DM; bf16_t* hr = h + (size_t)r * DM;
    f32x4 v[4]; float ss = 0.f;
#pragma unroll
    for (int q = 0; q < 4; ++q) { v[q] = *(const f32x4*)(xr + q * 256 + lane * 4); ss += v[q][0] * v[q][0] + v[q][1] * v[q][1] + v[q][2] * v[q][2] + v[q][3] * v[q][3]; }
    ss = wave_sum(ss); const float rs = rsqrtf(ss * (1.f / DM) + EPS);
#pragma unroll
    for (int q = 0; q < 4; ++q) { const f32x4 g = *(const f32x4*)((const float*)(p.ws + O_SMALL) + S_FFN + q * 256 + lane * 4);
      u32x2 w; w.x = cvtpk(v[q][0] * rs * g[0], v[q][1] * rs * g[1]); w.y = cvtpk(v[q][2] * rs * g[2], v[q][3] * rs * g[3]);
      *(u32x2*)(hr + q * 256 + lane * 4) = w; }
  }
}
LPHASE void rows_cnorm(char* ws_, const float* x_, float* out_, const float* meta_, int nseq_) { struct { char* ws; const float* meta; } p; p.ws = ws_; p.meta = meta_; Grp G; G.x = x_; G.out = out_; G.nseq = nseq_; G.Ls = nseq_ == 2 ? 8192 : 16384; G.RG = NREAL + 256 * nseq_;
  const int tix = TIDX(), lane = tix & 63, gw = BIDX() * 8 + (tix >> 6), nw = gridDim.x * 8;
  bf16_t* b1 = (bf16_t*)(p.ws + O_B1);
  const int nmeta8 = 32 * nseq_;
  if (gw < nmeta8) return;
  for (int r = gw - nmeta8; r < G.RG; r += nw - nmeta8) {
    bf16_t* br = b1 + (size_t)r * 1024;
    float a[8], b[8]; unpack8(*(const u32x4*)(br + lane * 8), a); unpack8(*(const u32x4*)(br + 512 + lane * 8), b);
    float sa = 0.f, sb = 0.f;
#pragma unroll
    for (int e = 0; e < 8; ++e) { sa += a[e] * a[e]; sb += b[e] * b[e]; }
    float sq = sa + (lane < 32 ? sb : 0.f), skv = (lane < 32 ? 0.f : sb);
    sq = wave_sum(sq); skv = wave_sum(skv);
    const float rq = rsqrtf(sq * (1.f / 768.f) + EPS), rkv = rsqrtf(skv * (1.f / 256.f) + EPS);
    const float* smq = (const float*)(p.ws + O_SMALL) + S_QA; const float* gb = lane < 32 ? smq + 512 + lane * 8 : (const float*)(p.ws + O_SMALL) + S_KVA + (lane * 8 - 256); const float rb = lane < 32 ? rq : rkv;
#pragma unroll
    for (int e = 0; e < 8; ++e) { a[e] *= rq * smq[lane * 8 + e]; b[e] *= rb * gb[e]; }
    *(u32x4*)(br + lane * 8) = pack8(a); *(u32x4*)(br + 512 + lane * 8) = pack8(b);
  }
}
LPHASE void rows_qk(char* ws_, const float* x_, float* out_, const float* meta_, int nseq_) { struct { char* ws; const float* meta; } p; p.ws = ws_; p.meta = meta_; Grp G; G.x = x_; G.out = out_; G.nseq = nseq_; G.Ls = nseq_ == 2 ? 8192 : 16384; G.RG = NREAL + 256 * nseq_;
  const int tix = TIDX(), lane = tix & 63, gw = BIDX() * 8 + (tix >> 6), nw = gridDim.x * 8;
  const bf16_t* qraw = (const bf16_t*)G.out; const bf16_t* knr = (const bf16_t*)(p.ws + O_KNR); const bf16_t* b4 = (const bf16_t*)(p.ws + O_B4);
  bf16_t* Q = (bf16_t*)(p.ws + O_QK); bf16_t* Kb = Q + (size_t)RGMAX * 1536;
  const int ri = lane & 31;
  const float inv = __expf(-(float)(2 * ri) * (1.f / 64.f) * 9.210340371976184f);
  const float* smn = (const float*)(p.ws + O_SMALL);
  const float qn0 = smn[S_QN + lane], qn1 = smn[S_QN + 64 + lane], qn2 = smn[S_QN + 128 + lane];
  const float kn0 = smn[S_KN + lane], kn1 = smn[S_KN + 64 + lane], kn2 = smn[S_KN + 128 + lane];
  for (int r = gw; r < G.RG; r += nw) {
    int pos; if (r < NREAL) pos = 16 + (r % G.Ls); else pos = (r - NREAL) & 255;
    float sn, cs; sincosf((float)pos * inv, &sn, &cs);
    const float kr = bf2f(b4[(size_t)r * 256 + lane]);
    for (int h = 0; h < 8; ++h) {
      { const bf16_t* s = knr + (size_t)r * 1024 + h * 128; float e0 = bf2f(s[lane]), e1 = bf2f(s[64 + lane]), e2 = kr;
        float ss = wave_sum(e0 * e0 + e1 * e1 + e2 * e2); const float rs = rsqrtf(ss * (1.f / 192.f) + EPS);
        e0 *= rs * kn0; e1 *= rs * kn1; e2 *= rs * kn2; const float pr = __shfl_xor(e2, 32);
        const float o2 = lane < 32 ? e2 * cs - pr * sn : e2 * cs + pr * sn;
        bf16_t* d = Kb + (size_t)r * 1536 + h * 192; d[lane] = f2bf(e0); d[64 + lane] = f2bf(e1); d[128 + lane] = f2bf(o2); }
    }
  }
}
LPHASE void rows_ogla(char* ws_, const float* x_, float* out_, const float* meta_, int nseq_) { struct { char* ws; const float* meta; } p; p.ws = ws_; p.meta = meta_; Grp G; G.x = x_; G.out = out_; G.nseq = nseq_; G.Ls = nseq_ == 2 ? 8192 : 16384; G.RG = NREAL + 256 * nseq_;
  const int tix = TIDX(), lane = tix & 63, gw = BIDX() * 8 + (tix >> 6), nw = gridDim.x * 8;
  const bf16_t* of = (const bf16_t*)(p.ws + O_OFB); const bf16_t* ob = of + (size_t)NREAL * 1024;
  const bf16_t* g3 = (const bf16_t*)(p.ws + O_G3); bf16_t* og = (bf16_t*)(p.ws + O_OGLA);
  for (int r = gw; r < NREAL; r += nw) {
    float a[16], b[8];
    unpack8(__builtin_nontemporal_load((const u32x4*)(of + (size_t)r * 1024 + lane * 16)), a); unpack8(__builtin_nontemporal_load((const u32x4*)(of + (size_t)r * 1024 + lane * 16 + 8)), a + 8);
    unpack8(__builtin_nontemporal_load((const u32x4*)(ob + (size_t)r * 1024 + lane * 16)), b);
#pragma unroll
    for (int e = 0; e < 8; ++e) a[e] += b[e];
    unpack8(__builtin_nontemporal_load((const u32x4*)(ob + (size_t)r * 1024 + lane * 16 + 8)), b);
#pragma unroll
    for (int e = 0; e < 8; ++e) a[8 + e] += b[e];
    float ss = 0.f;
#pragma unroll
    for (int e = 0; e < 16; ++e) ss += a[e] * a[e];
    ss += __shfl_xor(ss, 1); ss += __shfl_xor(ss, 2); ss += __shfl_xor(ss, 4); ss += __shfl_xor(ss, 8);
    const float rs = rsqrtf(ss * (1.f / 256.f) + EPS);
    float gg[16]; unpack8(__builtin_nontemporal_load((const u32x4*)(g3 + (size_t)r * 3072 + lane * 16)), gg); unpack8(__builtin_nontemporal_load((const u32x4*)(g3 + (size_t)r * 3072 + lane * 16 + 8)), gg + 8);
    const float* gn = (const float*)(p.ws + O_SMALL) + S_GON + ((lane * 16) & 255);
#pragma unroll
    for (int e = 0; e < 16; ++e) a[e] = a[e] * rs * gn[e] * (gg[e] * sigmoidf_(gg[e]));
    *(u32x4*)(og + (size_t)r * 1024 + lane * 16) = pack8(a); *(u32x4*)(og + (size_t)r * 1024 + lane * 16 + 8) = pack8(a + 8);
  }
}

constexpr int BM = 256, BK = 64, HALF = 128, HTB = HALF * BK * 2, NXCD = 8, WGM = 8;
__device__ __forceinline__ int lds_byte(int r, int c) { const int st = (r >> 4) * 2 + (c >> 5), rr = r & 15, cc = c & 31, ob = rr * 64 + cc * 2; return st * 1024 + (ob ^ (((ob >> 9) & 1) << 5)); }
__device__ __forceinline__ void stage_rc(int b, int& R, int& C) { const int st = b / 1024, sb = b % 1024, swz = sb ^ (((sb >> 9) & 1) << 5); R = (st >> 1) * 16 + swz / 64; C = (st & 1) * 32 + (swz % 64) / 2; }
__device__ __forceinline__ int perm32(int rho) { const int n = rho >> 4, i = rho & 15; return 8 * (i >> 2) + 4 * n + (i & 3); }
struct Unit { int pm, pn, w; };
struct Gemm { const bf16_t* A; const bf16_t* Bt; int lda, ldb, M, N, K; const bf16_t* A2; const bf16_t* Bt2; };
struct StaticOrder {
  int nM, nN, nwg, G, c, ntot;
  __device__ void init(int M, int N, int G_, int c_, bool dual) { nM = M / BM; nN = N / BM; nwg = nM * nN; ntot = dual ? 2 * nwg : nwg; G = G_; c = c_; }
  __device__ bool next(int i, Unit& u) const {
    const long L = (long)i * G + c; if (L >= ntot) return false;
    u.w = L >= nwg ? 1 : 0;
    int wgid = (int)(L - (u.w ? nwg : 0)); { const int q = nwg / NXCD, r = nwg % NXCD, xcd = wgid % NXCD, off = wgid / NXCD; wgid = (xcd < r ? xcd * (q + 1) : r * (q + 1) + (xcd - r) * q) + off; }
    const int nig = WGM * nN, gid = wgid / nig, fm = gid * WGM, gsz = (nM - fm) < WGM ? (nM - fm) : WGM;
    u.pm = fm + ((wgid % nig) % gsz); u.pn = (wgid % nig) / gsz; return true;
  }
};
template <class Epi>
__device__ __forceinline__ void gemm_phase(LAS unsigned char* lds, const Gemm g, const Epi& E) {
  int tid_ = threadIdx.x; asm volatile("" : "+v"(tid_));
  const int tid = tid_, wid = __builtin_amdgcn_readfirstlane(tid >> 6), lane = tid & 63, wr = wid >> 2, wc = wid & 3, fr = lane & 15, fq = lane >> 4;
  const int K = g.K, nt = K / BK;
  StaticOrder S; S.init(g.M, g.N, gridDim.x, blockIdx.x, g.A2 != nullptr);
  unsigned voffA[2], voffB[2];
#pragma unroll
  for (int i = 0; i < 2; ++i) { int R, C; stage_rc(tid * 16 + i * 8192, R, C); const int Rb = (R & ~31) + perm32(R & 31);
    voffA[i] = (unsigned)(R * g.lda + C) * 2u; voffB[i] = (unsigned)(Rb * g.ldb + C) * 2u; }
  const size_t kstep = (size_t)(BK * 2);
  const size_t hstepA = (size_t)HALF * g.lda * 2, hstepB = (size_t)HALF * g.ldb * 2;
  const size_t tstepA = 2 * hstepA, tstepB = 2 * hstepB;
  const unsigned ldsw = (unsigned)wid * 1024u;
  const int aoff = lds_byte(wr * 64 + fr, fq * 8), boff = lds_byte(wc * 32 + fr, fq * 8);
#define PG8_SA(b, h) (((b) * 2 + (h)) * HTB)
#define PG8_SB(b, h) ((4 + (b) * 2 + (h)) * HTB)
#define PG8_STAGE(bufoff, gbase, voff) do { _Pragma("unroll") for (int _i = 0; _i < 2; ++_i) \
    __builtin_amdgcn_global_load_lds((const unsigned*)((const char*)(gbase) + (voff)[_i]), (LAS unsigned*)(lds + (bufoff) + ldsw + _i * 8192), 16, 0, 0); } while (0)
#define PG8_LDA(dst, b, h) do { _Pragma("unroll") for (int m = 0; m < 4; ++m) _Pragma("unroll") for (int k = 0; k < 2; ++k) dst[m][k] = *(const LAS bf16x8*)(lds + PG8_SA(b, h) + aoff + m * 2048 + k * 1024); } while (0)
#define PG8_LDB(dst, b, h) do { _Pragma("unroll") for (int n = 0; n < 2; ++n) _Pragma("unroll") for (int k = 0; k < 2; ++k) dst[n][k] = *(const LAS bf16x8*)(lds + PG8_SB(b, h) + boff + n * 2048 + k * 1024); } while (0)
#define PG8_MMA(ai, bj, At, Bt) do { __builtin_amdgcn_s_setprio(1); _Pragma("unroll") for (int m = 0; m < 4; ++m) _Pragma("unroll") for (int n = 0; n < 2; ++n) _Pragma("unroll") for (int k = 0; k < 2; ++k) \
    acc[ai][bj][m][n] = __builtin_amdgcn_mfma_f32_16x16x32_bf16(Bt[n][k], At[m][k], acc[ai][bj][m][n], 0, 0, 0); __builtin_amdgcn_s_setprio(0); } while (0)
#define PG8_WAIT_V(n) asm volatile("s_waitcnt vmcnt(" #n ")" ::: "memory")
#define PG8_WAIT_L(n) asm volatile("s_waitcnt lgkmcnt(" #n ")" ::: "memory")
#define PG8_BAR __builtin_amdgcn_s_barrier()
#define PG8_SCHED __builtin_amdgcn_sched_barrier(0)
  Unit cur, nxt; int ui = 0;
  if (!S.next(0, cur)) return;
  f32x4 acc[2][2][4][2];
#pragma unroll
  for (int a = 0; a < 2; ++a)
#pragma unroll
    for (int b = 0; b < 2; ++b)
#pragma unroll
      for (int m = 0; m < 4; ++m)
#pragma unroll
        for (int n = 0; n < 2; ++n) acc[a][b][m][n] = (f32x4){0.f, 0.f, 0.f, 0.f};
  bf16x8 At[4][2], B0[2][2], B1[2][2];
  const char* cA = (const char*)(cur.w ? g.A2 : g.A) + (size_t)cur.pm * tstepA; const char* cB = (const char*)(cur.w ? g.Bt2 : g.Bt) + (size_t)cur.pn * tstepB;
  PG8_STAGE(PG8_SB(0, 0), cB, voffB); PG8_STAGE(PG8_SA(0, 0), cA, voffA); PG8_STAGE(PG8_SB(0, 1), cB + hstepB, voffB); PG8_STAGE(PG8_SA(0, 1), cA + hstepA, voffA);
  if (wr == 1) PG8_BAR;
  PG8_WAIT_V(4); PG8_BAR;
  PG8_STAGE(PG8_SB(1, 0), cB + kstep, voffB); PG8_STAGE(PG8_SA(1, 0), cA + kstep, voffA); PG8_STAGE(PG8_SB(1, 1), cB + hstepB + kstep, voffB);
  PG8_WAIT_V(6); PG8_BAR;
  for (;;) {
    const bool has_next = S.next(ui + 1, nxt);
    const char* nA = has_next ? (const char*)(nxt.w ? g.A2 : g.A) + (size_t)nxt.pm * tstepA : cA; const char* nB = has_next ? (const char*)(nxt.w ? g.Bt2 : g.Bt) + (size_t)nxt.pn * tstepB : cB;
    for (int t = 0; t < nt; t += 2) {
      const bool last = (t == nt - 2);
      const char* a1 = cA + (size_t)(t + 1) * kstep;
      const char* a2 = last ? nA : cA + (size_t)(t + 2) * kstep; const char* b2 = last ? nB : cB + (size_t)(t + 2) * kstep;
      const char* a3 = a2 + kstep; const char* b3 = b2 + kstep;
      PG8_LDB(B0, 0, 0); PG8_SCHED; PG8_LDA(At, 0, 0); PG8_STAGE(PG8_SA(1, 1), a1 + hstepA, voffA);
      PG8_WAIT_L(8); PG8_BAR; PG8_WAIT_L(0); PG8_MMA(0, 0, At, B0); PG8_BAR; PG8_SCHED;
      PG8_LDB(B1, 0, 1); PG8_STAGE(PG8_SB(0, 0), b2, voffB);
      PG8_BAR; PG8_WAIT_L(0); PG8_MMA(0, 1, At, B1); PG8_BAR;
      PG8_LDA(At, 0, 1); PG8_STAGE(PG8_SA(0, 0), a2, voffA);
      PG8_BAR; PG8_WAIT_L(0); PG8_MMA(1, 0, At, B0); PG8_BAR; PG8_SCHED;
      PG8_STAGE(PG8_SB(0, 1), b2 + hstepB, voffB);
      PG8_WAIT_V(6); PG8_BAR; PG8_MMA(1, 1, At, B1); PG8_BAR;
      PG8_LDB(B0, 1, 0); PG8_SCHED; PG8_LDA(At, 1, 0); PG8_STAGE(PG8_SA(0, 1), a2 + hstepA, voffA);
      PG8_WAIT_L(8); PG8_BAR; PG8_WAIT_L(0); PG8_MMA(0, 0, At, B0); PG8_BAR; PG8_SCHED;
      PG8_LDB(B1, 1, 1); PG8_STAGE(PG8_SB(1, 0), b3, voffB);
      PG8_BAR; PG8_WAIT_L(0); PG8_MMA(0, 1, At, B1); PG8_BAR;
      PG8_LDA(At, 1, 1); PG8_STAGE(PG8_SA(1, 0), a3, voffA);
      PG8_BAR; PG8_WAIT_L(0); PG8_MMA(1, 0, At, B0); PG8_BAR; PG8_SCHED;
      PG8_STAGE(PG8_SB(1, 1), b3 + hstepB, voffB);
      PG8_WAIT_V(6); PG8_BAR; PG8_MMA(1, 1, At, B1); PG8_BAR;
    }
    {
#pragma unroll
      for (int ai = 0; ai < 2; ++ai)
#pragma unroll
        for (int m = 0; m < 4; ++m)
#pragma unroll
          for (int bj = 0; bj < 2; ++bj)
          { E.st2(cur.w, cur.pm * BM + ai * HALF + wr * 64 + m * 16 + fr, cur.pn * BM + bj * HALF + wc * 32 + 8 * fq, acc[ai][bj][m][0], acc[ai][bj][m][1]); if (bj == 1 && (m & 1)) asm volatile("" ::: "memory"); }
    }
    if (!has_next) break;
#pragma unroll
    for (int a = 0; a < 2; ++a)
#pragma unroll
      for (int b = 0; b < 2; ++b)
#pragma unroll
        for (int m = 0; m < 4; ++m)
#pragma unroll
          for (int n = 0; n < 2; ++n) acc[a][b][m][n] = (f32x4){0.f, 0.f, 0.f, 0.f};
    cur = nxt; cA = nA; cB = nB; ++ui;
  }
  PG8_WAIT_V(0);
  if (wr == 0) PG8_BAR;
  PG8_BAR;
#undef PG8_SA
#undef PG8_SB
#undef PG8_STAGE
#undef PG8_LDA
#undef PG8_LDB
#undef PG8_MMA
#undef PG8_WAIT_V
#undef PG8_WAIT_L
#undef PG8_BAR
#undef PG8_SCHED
}

__device__ __forceinline__ u32x4 pk8(f32x4 a, f32x4 b) { u32x4 w; w.x = cvtpk(a[0], a[1]); w.y = cvtpk(a[2], a[3]); w.z = cvtpk(b[0], b[1]); w.w = cvtpk(b[2], b[3]); return w; }
struct EpiInproj { bf16_t *b1, *b2, *g3, *b4;
  __device__ __forceinline__ void st(int r, int c, f32x4 v0, f32x4 v1) const {
    const u32x4 w = pk8(v0, v1);
    if (c < 1024) *(u32x4*)(b1 + (size_t)r * 1024 + c) = w;
    else if (c < 3072) *(u32x4*)(b2 + (size_t)r * 2048 + (c - 1024)) = w;
    else if (c < 6144) { if (r < NREAL) *(u32x4*)(g3 + (size_t)r * 3072 + (c - 3072)) = w; }
    else *(u32x4*)(b4 + (size_t)r * 256 + (c - 6144)) = w; } };
struct EpiBf16 { bf16_t* o; int ld;
  __device__ __forceinline__ void st(int r, int c, f32x4 v0, f32x4 v1) const { *(u32x4*)(o + (size_t)r * ld + c) = pk8(v0, v1); } };
struct EpiKV { bf16_t *kn, *v;
  __device__ __forceinline__ void st(int r, int c, f32x4 v0, f32x4 v1) const {
    if (c < 1024) *(u32x4*)(kn + (size_t)r * 1024 + c) = pk8(v0, v1); else *(u32x4*)(v + (size_t)r * 1024 + (c - 1024)) = pk8(v0, v1); } };
struct EpiGateA { const bf16_t* g3; bf16_t* tmp;
  __device__ __forceinline__ void st(int r, int c, f32x4 v0, f32x4 v1) const {
    float g[8]; unpack8(*(const u32x4*)(g3 + (size_t)r * 3072 + 1024 + c), g);
    f32x4 a, b;
#pragma unroll
    for (int e = 0; e < 4; ++e) { a[e] = v0[e] * sigmoidf_(g[e]); b[e] = v1[e] * sigmoidf_(g[4 + e]); }
    *(u32x4*)(tmp + (size_t)r * 1024 + c) = pk8(a, b); } };
struct EpiGateB { const bf16_t* g3; const bf16_t* tmp; bf16_t* m;
  __device__ __forceinline__ void st(int r, int c, f32x4 v0, f32x4 v1) const {
    float g[8]; unpack8(*(const u32x4*)(g3 + (size_t)r * 3072 + 2048 + c), g);
    float t[8]; unpack8(*(const u32x4*)(tmp + (size_t)r * 1024 + c), t);
    f32x4 a = (f32x4){t[0], t[1], t[2], t[3]}, b = (f32x4){t[4], t[5], t[6], t[7]};
#pragma unroll
    for (int e = 0; e < 4; ++e) { a[e] += v0[e] * sigmoidf_(g[e]); b[e] += v1[e] * sigmoidf_(g[4 + e]); }
    *(u32x4*)(m + (size_t)r * 1024 + c) = pk8(a, b); } };
struct EpiX1 { const float* x; float* out;
  __device__ __forceinline__ void st(int r, int c, f32x4 v0, f32x4 v1) const {
    const f32x4 a = __builtin_nontemporal_load((const f32x4*)(x + (size_t)r * 1024 + c)), b = __builtin_nontemporal_load((const f32x4*)(x + (size_t)r * 1024 + c + 4));
    *(f32x4*)(out + (size_t)r * 1024 + c) = a + v0; *(f32x4*)(out + (size_t)r * 1024 + c + 4) = b + v1; } };
struct EpiFfnUp { bf16_t* act;
  __device__ __forceinline__ void st(int r, int c, f32x4 v0, f32x4 v1) const {
    float o[4];
#pragma unroll
    for (int e = 0; e < 4; ++e) o[e] = v0[e] * sigmoidf_(v0[e]) * v1[e];
    u32x2 w; w.x = cvtpk(o[0], o[1]); w.y = cvtpk(o[2], o[3]); *(u32x2*)(act + (size_t)r * DFF + (c >> 1)) = w; } };
struct EpiFfnDown { float* out;
  __device__ __forceinline__ void st(int r, int c, f32x4 v0, f32x4 v1) const {
    float* o = out + (size_t)r * 1024 + c; const f32x4 a = __builtin_nontemporal_load((const f32x4*)o), b = __builtin_nontemporal_load((const f32x4*)(o + 4));
    __builtin_nontemporal_store(a + v0, (f32x4*)o); __builtin_nontemporal_store(b + v1, (f32x4*)(o + 4)); } };

constexpr int LDQ = 1536, LDK = 1536, LDV = 1024, LDO = 1024;
constexpr int SHM_V = 64 * 128 * 2, SHM_K = 64 * 192 * 2;
constexpr float ATT_SCALE = 0.07216878364870322f;
constexpr float ATT_THR = 8.f;
#define KSWZ(row, colB) ((row) * 384 + ((colB) ^ (((row) & 7) << 4)))
__device__ __forceinline__ int crow(int r, int hi) { return (r & 3) + 8 * (r >> 2) + 4 * hi; }
__device__ __forceinline__ void partialSM(f32x16& p0, f32x16& p1, float& m_reg, float& mn, float& alpha) {
  constexpr float C = ATT_SCALE * 1.4426950408889634f;
  float pmax = p0[0];
#pragma unroll
  for (int r = 1; r < 16; ++r) pmax = fmaxf(pmax, p0[r]);
#pragma unroll
  for (int r = 0; r < 16; ++r) pmax = fmaxf(pmax, p1[r]);
  { auto rr = __builtin_amdgcn_permlane32_swap(__float_as_uint(pmax), __float_as_uint(pmax), false, false);
    pmax = fmaxf(__uint_as_float(rr[0]), __uint_as_float(rr[1])); }
  if (__builtin_expect(__all(pmax - m_reg <= ATT_THR / ATT_SCALE), 1)) { mn = m_reg; alpha = 1.f; }
  else { mn = fmaxf(m_reg, pmax); alpha = __builtin_amdgcn_exp2f((m_reg - mn) * C); m_reg = mn; }
  const float mnC = -mn * C;
#pragma unroll
  for (int r = 0; r < 16; ++r) p0[r] = fmaf(p0[r], C, mnC);
#pragma unroll
  for (int r = 0; r < 16; ++r) p1[r] = fmaf(p1[r], C, mnC);
#pragma unroll
  for (int r = 0; r < 16; ++r) p0[r] = __builtin_amdgcn_exp2f(p0[r]);
}
__device__ __forceinline__ void finishSM(f32x16& p0, f32x16& p1, float alpha, float& l_reg, bf16x8& pa0, bf16x8& pa1, bf16x8& pa2, bf16x8& pa3) {
#pragma unroll
  for (int r = 0; r < 16; ++r) p1[r] = __builtin_amdgcn_exp2f(p1[r]);
  float ps = 0;
#pragma unroll
  for (int r = 0; r < 16; ++r) ps += p0[r];
#pragma unroll
  for (int r = 0; r < 16; ++r) ps += p1[r];
  { auto rr = __builtin_amdgcn_permlane32_swap(__float_as_uint(ps), __float_as_uint(ps), false, false);
    ps = __uint_as_float(rr[0]) + __uint_as_float(rr[1]); }
  l_reg = l_reg * alpha + ps;
#define PK4(P, BASE, OUT) do { unsigned a0 = cvtpk(P[BASE + 0], P[BASE + 1]), a1 = cvtpk(P[BASE + 2], P[BASE + 3]);   \
    unsigned b0 = cvtpk(P[BASE + 4], P[BASE + 5]), b1 = cvtpk(P[BASE + 6], P[BASE + 7]);                              \
    auto r0 = __builtin_amdgcn_permlane32_swap(a0, b0, false, false); auto r1 = __builtin_amdgcn_permlane32_swap(a1, b1, false, false); \
    u32x4 w = {r0[0], r1[0], r0[1], r1[1]}; OUT = *reinterpret_cast<bf16x8*>(&w); } while (0)
  PK4(p0, 0, pa0); PK4(p0, 8, pa1); PK4(p1, 0, pa2); PK4(p1, 8, pa3);
#undef PK4
}
__device__ __forceinline__ void qkt(f32x16& p0, f32x16& p1, const char* Ks, const bf16x8* qr, const char* qx, int r32, int hi, int mode) {
  p0 = f32x16{}; p1 = f32x16{};
#pragma unroll
  for (int d0 = 0; d0 < 12; ++d0) { const int cb = (d0 * 16 + hi * 8) * 2;
    bf16x8 b0 = *reinterpret_cast<const bf16x8*>(Ks + KSWZ(r32, cb));
    bf16x8 b1 = *reinterpret_cast<const bf16x8*>(Ks + KSWZ(32 + r32, cb));
    const bf16x8 qf = d0 < 8 ? qr[d0 < 8 ? d0 : 0] : *reinterpret_cast<const bf16x8*>(qx + (d0 - 8) * 1024);
    p0 = __builtin_amdgcn_mfma_f32_32x32x16_bf16(b0, qf, p0, 0, 0, 0);
    p1 = __builtin_amdgcn_mfma_f32_32x32x16_bf16(b1, qf, p1, 0, 0, 0); }
  if (mode != 0) {
    constexpr float NEG = -1e30f;
#pragma unroll
    for (int r = 0; r < 16; ++r) p1[r] = NEG;
#pragma unroll
    for (int r = 8; r < 16; ++r) p0[r] = NEG;
    if (mode == 2) {
#pragma unroll
      for (int r = 0; r < 8; ++r) p0[r] = NEG; }
  }
}
__device__ __forceinline__ int v_st(int k, int c) { const int kk = (k & ~0xC) | ((k & 4) << 1) | ((k & 8) >> 1); return ((kk >> 3) * 4 + (c >> 5)) * 512 + ((kk & 7) * 32 + (c & 31)) * 2; }
__device__ __forceinline__ int v_rd_base(int lane) { return ((lane & 3) << 3) | (((lane >> 2) & 3) << 6) | (((lane >> 4) & 1) << 5) | (((lane >> 5) & 1) << 8); }
constexpr int v_rd_off(int d0, int ks, int half) { return d0 * 512 + ks * 4096 + half * 2048; }
template <int OFF> __device__ __forceinline__ s16x4 tr_read(int vb) {
  s16x4 r; asm volatile("ds_read_b64_tr_b16 %0, %1 offset:%2" : "=&v"(r) : "v"(vb), "i"(OFF) : "memory"); return r;
}
template <int D0> __device__ __forceinline__ void pv_one(f32x16& od, int vb, bf16x8 pa0, bf16x8 pa1, bf16x8 pa2, bf16x8 pa3) {
  const s16x4 l0 = tr_read<v_rd_off(D0, 0, 0)>(vb), h0 = tr_read<v_rd_off(D0, 0, 1)>(vb), l1 = tr_read<v_rd_off(D0, 1, 0)>(vb), h1 = tr_read<v_rd_off(D0, 1, 1)>(vb);
  const s16x4 l2 = tr_read<v_rd_off(D0, 2, 0)>(vb), h2 = tr_read<v_rd_off(D0, 2, 1)>(vb), l3 = tr_read<v_rd_off(D0, 3, 0)>(vb), h3 = tr_read<v_rd_off(D0, 3, 1)>(vb);
  asm volatile("s_waitcnt lgkmcnt(0)" ::: "memory"); SBAR();
#define PK(L, H) (bf16x8){L[0], L[1], L[2], L[3], H[0], H[1], H[2], H[3]}
  od = __builtin_amdgcn_mfma_f32_32x32x16_bf16(pa0, PK(l0, h0), od, 0, 0, 0);
  od = __builtin_amdgcn_mfma_f32_32x32x16_bf16(pa1, PK(l1, h1), od, 0, 0, 0);
  od = __builtin_amdgcn_mfma_f32_32x32x16_bf16(pa2, PK(l2, h2), od, 0, 0, 0);
  od = __builtin_amdgcn_mfma_f32_32x32x16_bf16(pa3, PK(l3, h3), od, 0, 0, 0);
#undef PK
}
__device__ __forceinline__ void pv_d0(f32x16* o, int vb, bf16x8 pa0, bf16x8 pa1, bf16x8 pa2, bf16x8 pa3) {
  pv_one<0>(o[0], vb, pa0, pa1, pa2, pa3); pv_one<1>(o[1], vb, pa0, pa1, pa2, pa3); pv_one<2>(o[2], vb, pa0, pa1, pa2, pa3); pv_one<3>(o[3], vb, pa0, pa1, pa2, pa3);
}
__device__ __forceinline__ void attn_body(const bf16_t* __restrict__ Qb, const bf16_t* __restrict__ Kh, const bf16_t* __restrict__ Vh,
                                          bf16_t* __restrict__ Ob, int krow0, int mrow0, int ntr, char* lds, int pos0, const float* __restrict__ qn) {
  int tid_ = threadIdx.x; asm volatile("" : "+v"(tid_));
  const int tid = tid_, wid = tid >> 6, lane = tid & 63, r32 = lane & 31, hi = lane >> 5;
  char* V_lds = lds; char* K_lds = lds + 2 * SHM_V;
  float* wsf = (float*)(lds + 2 * SHM_V + 2 * SHM_K) + wid * 64; float* li_l = wsf; float* al_l = wsf + 32;
  bf16x8 qr[8];
  char* qx = lds + 2 * SHM_V + 2 * SHM_K + 2048 + wid * 4096 + lane * 16;
  {
    float csv[16], snv[16];
    { const float posf = (float)(pos0 + wid * 32 + r32);
#pragma unroll
      for (int k = 0; k < 16; ++k) { const int i = 16 * (k >> 3) + 8 * hi + (k & 7);
        const float inv = __expf(-(float)(2 * i) * (1.f / 64.f) * 9.210340371976184f);
        sincosf(posf * inv, &snv[k], &csv[k]); asm volatile("" : "+v"(snv[k]), "+v"(csv[k])); } }
    const bf16_t* Qw = Qb + (long)(wid * 32 + r32) * LDQ + hi * 8;
    float xf[12][8]; float ss = 0.f;
#pragma unroll
    for (int d0 = 0; d0 < 12; ++d0) { unpack8(*reinterpret_cast<const u32x4*>(Qw + d0 * 16), xf[d0]);
#pragma unroll
      for (int e = 0; e < 8; ++e) ss += xf[d0][e] * xf[d0][e]; }
    ss += __shfl_xor(ss, 32);
    const float rs = rsqrtf(ss * (1.f / 192.f) + EPS);
#pragma unroll
    for (int d0 = 0; d0 < 12; ++d0) { const f32x4 g0 = *(const f32x4*)(qn + d0 * 16 + hi * 8), g1 = *(const f32x4*)(qn + d0 * 16 + hi * 8 + 4);
#pragma unroll
      for (int e = 0; e < 4; ++e) { xf[d0][e] *= rs * g0[e]; xf[d0][4 + e] *= rs * g1[e]; } }
#pragma unroll
    for (int dd = 0; dd < 2; ++dd)
#pragma unroll
      for (int e = 0; e < 8; ++e) { const float sn = snv[8 * dd + e], cs = csv[8 * dd + e];
        const float x1 = xf[8 + dd][e], x2 = xf[10 + dd][e];
        xf[8 + dd][e] = x1 * cs - x2 * sn; xf[10 + dd][e] = x2 * cs + x1 * sn; }
#pragma unroll
    for (int d0 = 0; d0 < 8; ++d0) { const u32x4 w = pack8(xf[d0]); qr[d0] = *reinterpret_cast<const bf16x8*>(&w); }
#pragma unroll
    for (int d0 = 8; d0 < 12; ++d0) *reinterpret_cast<u32x4*>(qx + (d0 - 8) * 1024) = pack8(xf[d0]);
  }
  float m_reg = -1e30f, l_reg = 0; f32x16 o[4] = {};
  const int sr = tid >> 4, sc = (tid & 15) * 8, vst0 = v_st(sr, sc), vst1 = v_st(32 + sr, sc);
  const int kr2 = tid >> 3, kc2 = 128 + (tid & 7) * 8;
  const int vb0 = (int)(uintptr_t)V_lds + v_rd_base(lane);
  const int NT = ntr + 2;
  bf16x8 vs0, vs1, ks0, ks1, ks2;
#define TROW(j) ((j) < ntr ? krow0 + (j) * 64 : mrow0 + ((j) - ntr) * 64)
  const unsigned voV = (unsigned)(sr * LDV + sc) * 2u, voK = (unsigned)(sr * LDK + sc) * 2u, voK2 = (unsigned)(kr2 * LDK + kc2) * 2u;
#define SLOAD(j) do { const long _k0 = TROW(j); const char* _vt = (const char*)Vh + _k0 * (LDV * 2); const char* _kt = (const char*)Kh + _k0 * (LDK * 2); \
    vs0 = *reinterpret_cast<const bf16x8*>(_vt + voV); vs1 = *reinterpret_cast<const bf16x8*>(_vt + 32 * LDV * 2 + voV); \
    ks0 = *reinterpret_cast<const bf16x8*>(_kt + voK); ks1 = *reinterpret_cast<const bf16x8*>(_kt + 32 * LDK * 2 + voK); \
    ks2 = *reinterpret_cast<const bf16x8*>(_kt + voK2); } while (0)
#define SWRITE(b) do { *(bf16x8*)(V_lds + (b) * SHM_V + vst0) = vs0; *(bf16x8*)(V_lds + (b) * SHM_V + vst1) = vs1; const int kc = sc * 2; \
    *(bf16x8*)(K_lds + (b) * SHM_K + KSWZ(sr, kc)) = ks0; *(bf16x8*)(K_lds + (b) * SHM_K + KSWZ(32 + sr, kc)) = ks1; \
    *(bf16x8*)(K_lds + (b) * SHM_K + KSWZ(kr2, kc2 * 2)) = ks2; } while (0)
#define SWAIT() asm volatile("s_waitcnt vmcnt(0)" ::: "memory")
#define RESC(a) do { if (__any((a) < 1.f)) { if (hi == 0) al_l[r32] = (a); asm volatile("s_waitcnt lgkmcnt(0)" ::: "memory"); \
    for (int d = 0; d < 4; ++d) for (int r = 0; r < 16; ++r) o[d][r] *= al_l[crow(r, hi)]; } } while (0)
  f32x16 pA0, pA1, pB0, pB1; float mnA, mnB, alA, alB; bf16x8 pa0, pa1, pa2, pa3;
  SLOAD(0); SWAIT(); SWRITE(0); __syncthreads();
  qkt(pA0, pA1, K_lds, qr, qx, r32, hi, 0); partialSM(pA0, pA1, m_reg, mnA, alA);
  SLOAD(1);
  SWAIT(); SWRITE(1); __syncthreads();
  for (int j = 1; j + 1 < NT; j += 2) {
    SBAR(); qkt(pB0, pB1, K_lds + SHM_K, qr, qx, r32, hi, 0);
    finishSM(pA0, pA1, alA, l_reg, pa0, pa1, pa2, pa3); SBAR();
    SLOAD(j + 1); SBAR();
    pv_d0(o, vb0, pa0, pa1, pa2, pa3); partialSM(pB0, pB1, m_reg, mnB, alB);
    __syncthreads(); SWAIT(); SWRITE(0);
    RESC(alB); __syncthreads();
    SBAR(); qkt(pA0, pA1, K_lds, qr, qx, r32, hi, (j + 1 == ntr) ? 1 : 0);
    finishSM(pB0, pB1, alB, l_reg, pa0, pa1, pa2, pa3); SBAR();
    SLOAD(j + 2); SBAR();
    pv_d0(o, vb0 + SHM_V, pa0, pa1, pa2, pa3); partialSM(pA0, pA1, m_reg, mnA, alA);
    __syncthreads(); SWAIT(); SWRITE(1);
    RESC(alA); __syncthreads();
  }
  SBAR(); qkt(pB0, pB1, K_lds + SHM_K, qr, qx, r32, hi, 2);
  finishSM(pA0, pA1, alA, l_reg, pa0, pa1, pa2, pa3); SBAR();
  pv_d0(o, vb0, pa0, pa1, pa2, pa3); partialSM(pB0, pB1, m_reg, mnB, alB);
  __syncthreads(); RESC(alB);
  finishSM(pB0, pB1, alB, l_reg, pa0, pa1, pa2, pa3); SBAR();
  pv_d0(o, vb0 + SHM_V, pa0, pa1, pa2, pa3);
  if (hi == 0) li_l[r32] = l_reg; asm volatile("s_waitcnt lgkmcnt(0)" ::: "memory");
  float rli[16];
#pragma unroll
  for (int r = 0; r < 16; ++r) rli[r] = __builtin_amdgcn_rcpf(li_l[crow(r, hi)]);
  bf16_t* Ow = Ob + (long)(wid * 32) * LDO;
#pragma unroll
  for (int r = 0; r < 16; ++r) { const int orow = crow(r, hi);
#pragma unroll
    for (int d0 = 0; d0 < 4; ++d0) Ow[(long)orow * LDO + d0 * 32 + r32] = f2bf(o[d0][r] * rli[r]); }
  __syncthreads();
#undef TROW
#undef SLOAD
#undef SWRITE
#undef SWAIT
#undef RESC
}
__device__ __forceinline__ void qkt12(f32x16& p0, f32x16& p1, const char* Ks, const bf16x8* qr, int r32, int hi, int mode) {
  p0 = f32x16{}; p1 = f32x16{};
#pragma unroll
  for (int d0 = 0; d0 < 12; ++d0) { const int cb = (d0 * 16 + hi * 8) * 2;
    bf16x8 b0 = *reinterpret_cast<const bf16x8*>(Ks + KSWZ(r32, cb));
    bf16x8 b1 = *reinterpret_cast<const bf16x8*>(Ks + KSWZ(32 + r32, cb));
    p0 = __builtin_amdgcn_mfma_f32_32x32x16_bf16(b0, qr[d0], p0, 0, 0, 0);
    p1 = __builtin_amdgcn_mfma_f32_32x32x16_bf16(b1, qr[d0], p1, 0, 0, 0); }
  if (mode != 0) {
    constexpr float NEG = -1e30f;
#pragma unroll
    for (int r = 0; r < 16; ++r) p1[r] = NEG;
#pragma unroll
    for (int r = 8; r < 16; ++r) p0[r] = NEG;
    if (mode == 2) {
#pragma unroll
      for (int r = 0; r < 8; ++r) p0[r] = NEG; }
  }
}
constexpr int A2_K = 2 * SHM_V, A2_WS = A2_K + 2 * SHM_K;
__device__ __forceinline__ void attn_body2(const bf16_t* __restrict__ Qb, const bf16_t* __restrict__ Kh, const bf16_t* __restrict__ Vh,
                                           bf16_t* __restrict__ Ob, int krow0, int mrow0, int ntr, char* lds, LAS unsigned char* ldsL, int pos0, const float* __restrict__ qn) {
  int tid_ = threadIdx.x; asm volatile("" : "+v"(tid_));
  const int tid = tid_, wid = __builtin_amdgcn_readfirstlane(tid >> 6), lane = tid & 63, r32 = lane & 31, hi = lane >> 5;
  char* V_lds = lds; char* K_lds = lds + A2_K;
  float* wsf = (float*)(lds + A2_WS) + wid * 64; float* li_l = wsf; float* al_l = wsf + 32;
  bf16x8 qr[8];
  char* qx = lds + A2_WS + 2048 + wid * 4096 + lane * 16;
  { float csv[16], snv[16];
    { const float posf = (float)(pos0 + wid * 32 + r32);
#pragma unroll
      for (int k = 0; k < 16; ++k) { const int i = 16 * (k >> 3) + 8 * hi + (k & 7);
        const float inv = __expf(-(float)(2 * i) * (1.f / 64.f) * 9.210340371976184f);
        sincosf(posf * inv, &snv[k], &csv[k]); asm volatile("" : "+v"(snv[k]), "+v"(csv[k])); } }
    const bf16_t* Qw = Qb + (long)(wid * 32 + r32) * LDQ + hi * 8;
    float xf[12][8]; float ss = 0.f;
#pragma unroll
    for (int d0 = 0; d0 < 12; ++d0) { unpack8(*reinterpret_cast<const u32x4*>(Qw + d0 * 16), xf[d0]);
#pragma unroll
      for (int e = 0; e < 8; ++e) ss += xf[d0][e] * xf[d0][e]; }
    ss += __shfl_xor(ss, 32);
    const float rs = rsqrtf(ss * (1.f / 192.f) + EPS);
#pragma unroll
    for (int d0 = 0; d0 < 12; ++d0) { const f32x4 g0 = *(const f32x4*)(qn + d0 * 16 + hi * 8), g1 = *(const f32x4*)(qn + d0 * 16 + hi * 8 + 4);
#pragma unroll
      for (int e = 0; e < 4; ++e) { xf[d0][e] *= rs * g0[e]; xf[d0][4 + e] *= rs * g1[e]; } }
#pragma unroll
    for (int dd = 0; dd < 2; ++dd)
#pragma unroll
      for (int e = 0; e < 8; ++e) { const float sn = snv[8 * dd + e], cs = csv[8 * dd + e];
        const float x1 = xf[8 + dd][e], x2 = xf[10 + dd][e];
        xf[8 + dd][e] = x1 * cs - x2 * sn; xf[10 + dd][e] = x2 * cs + x1 * sn; }
#pragma unroll
    for (int d0 = 0; d0 < 8; ++d0) { const u32x4 w = pack8(xf[d0]); qr[d0] = *reinterpret_cast<const bf16x8*>(&w); }
#pragma unroll
    for (int d0 = 8; d0 < 12; ++d0) *reinterpret_cast<u32x4*>(qx + (d0 - 8) * 1024) = pack8(xf[d0]);
  }
  float m_reg = -1e30f, l_reg = 0; f32x16 o[4] = {};
  unsigned okk[3], ovv[2];
#pragma unroll
  for (int i = 0; i < 3; ++i) { const int sl = (wid * 3 + i) * 64 + lane, row = sl / 24, cp = sl - row * 24, ch = cp ^ (row & 7); okk[i] = (unsigned)(row * (LDK * 2) + ch * 16); }
#pragma unroll
  for (int i = 0; i < 2; ++i) { const int sl = (wid * 2 + i) * 64 + lane, sub = sl >> 5, kk = (sub >> 2) * 8 + ((sl & 31) >> 2), c = (sub & 3) * 32 + (sl & 3) * 8;
    const int k = (kk & ~0xC) | ((kk & 4) << 1) | ((kk & 8) >> 1); ovv[i] = (unsigned)(k * (LDV * 2) + c * 2); }
  const int vb0 = (int)(uintptr_t)V_lds + v_rd_base(lane);
  const int NT = ntr + 2;
#define TROW(j) ((j) < ntr ? krow0 + (j) * 64 : mrow0 + ((j) - ntr) * 64)
#define ISSUE_K(j, stg) do { const long _k0 = TROW(j); const char* _kt = (const char*)Kh + _k0 * (LDK * 2); _Pragma("unroll") for (int _i = 0; _i < 3; ++_i) \
    __builtin_amdgcn_global_load_lds((const unsigned*)(_kt + okk[_i]), (LAS unsigned*)(ldsL + A2_K + (stg) * SHM_K + (wid * 3 + _i) * 1024), 16, 0, 0); } while (0)
#define ISSUE_V(j, stg) do { const long _k0 = TROW(j); const char* _vt = (const char*)Vh + _k0 * (LDV * 2); _Pragma("unroll") for (int _i = 0; _i < 2; ++_i) \
    __builtin_amdgcn_global_load_lds((const unsigned*)(_vt + ovv[_i]), (LAS unsigned*)(ldsL + (stg) * SHM_V + (wid * 2 + _i) * 1024), 16, 0, 0); } while (0)
#define WAITV(n) asm volatile("s_waitcnt vmcnt(" #n ")" ::: "memory")
#define ABAR() do { asm volatile("s_waitcnt lgkmcnt(0)" ::: "memory"); __builtin_amdgcn_s_barrier(); asm volatile("" ::: "memory"); } while (0)
#define RESC(a) do { if (__any((a) < 1.f)) { if (hi == 0) al_l[r32] = (a); asm volatile("s_waitcnt lgkmcnt(0)" ::: "memory"); \
    for (int d = 0; d < 4; ++d) for (int r = 0; r < 16; ++r) o[d][r] *= al_l[crow(r, hi)]; } } while (0)
  f32x16 pA0, pA1, pB0, pB1; float mnA, mnB, alA, alB; bf16x8 pa0, pa1, pa2, pa3;
  ISSUE_K(0, 0);
  WAITV(0); ABAR();
  ISSUE_K(1, 1); ISSUE_V(0, 0);
  qkt(pA0, pA1, K_lds, qr, qx, r32, hi, 0); partialSM(pA0, pA1, m_reg, mnA, alA);
  WAITV(0); ABAR();
  for (int j = 1; j + 1 < NT; j += 2) {
    ISSUE_K(j + 1, 0); ISSUE_V(j, 1);
    SBAR(); qkt(pB0, pB1, K_lds + SHM_K, qr, qx, r32, hi, 0);
    finishSM(pA0, pA1, alA, l_reg, pa0, pa1, pa2, pa3); SBAR();
    pv_d0(o, vb0, pa0, pa1, pa2, pa3); partialSM(pB0, pB1, m_reg, mnB, alB);
    RESC(alB); WAITV(0); ABAR();
    ISSUE_K(j + 2, 1); ISSUE_V(j + 1, 0);
    SBAR(); qkt(pA0, pA1, K_lds, qr, qx, r32, hi, (j + 1 == ntr) ? 1 : 0);
    finishSM(pB0, pB1, alB, l_reg, pa0, pa1, pa2, pa3); SBAR();
    pv_d0(o, vb0 + SHM_V, pa0, pa1, pa2, pa3); partialSM(pA0, pA1, m_reg, mnA, alA);
    RESC(alA); WAITV(0); ABAR();
  }
  ISSUE_V(NT - 1, 1);
  SBAR(); qkt(pB0, pB1, K_lds + SHM_K, qr, qx, r32, hi, 2);
  finishSM(pA0, pA1, alA, l_reg, pa0, pa1, pa2, pa3); SBAR();
  pv_d0(o, vb0, pa0, pa1, pa2, pa3); partialSM(pB0, pB1, m_reg, mnB, alB);
  WAITV(0); ABAR(); RESC(alB);
  finishSM(pB0, pB1, alB, l_reg, pa0, pa1, pa2, pa3); SBAR();
  pv_d0(o, vb0 + SHM_V, pa0, pa1, pa2, pa3);
  if (hi == 0) li_l[r32] = l_reg; asm volatile("s_waitcnt lgkmcnt(0)" ::: "memory");
  float rli[16];
#pragma unroll
  for (int r = 0; r < 16; ++r) rli[r] = __builtin_amdgcn_rcpf(li_l[crow(r, hi)]);
  bf16_t* Ow = Ob + (long)(wid * 32) * LDO;
#pragma unroll
  for (int r = 0; r < 16; ++r) { const int orow = crow(r, hi);
#pragma unroll
    for (int d0 = 0; d0 < 4; ++d0) Ow[(long)orow * LDO + d0 * 32 + r32] = f2bf(o[d0][r] * rli[r]); }
  ABAR();
#undef TROW
#undef ISSUE_K
#undef ISSUE_V
#undef WAITV
#undef ABAR
#undef RESC
}
__device__ void phase_attn(const Params& p0, const Grp& G, char* lds, LAS unsigned char* ldsL) { Params p = p0; p.ws = opaque(p0.ws);
  const bf16_t* Q = (const bf16_t*)G.out;
  const bf16_t* Kb = (const bf16_t*)(p.ws + O_QK) + (size_t)RGMAX * 1536; const bf16_t* Vb = (const bf16_t*)(p.ws + O_V);
  const float* qn = (const float*)(p.ws + O_SMALL) + S_QN;
  bf16_t* O = (bf16_t*)(p.ws + O_OMLA);
  const int nqb = G.Ls / 256;
  const int nitems = G.nseq * 8 * nqb;
  for (int it = BIDX(); it < nitems; it += gridDim.x) {
    const int h = it & 7, rest = it >> 3, s = rest / nqb, qb = rest % nqb;
    const int qrow = s * G.Ls + qb * 256;
#ifdef ATTN_REGSTAGE
    attn_body(Q + (size_t)qrow * LDQ + h * 192, Kb + h * 192, Vb + h * 128, O + (size_t)qrow * LDO + h * 128, s * G.Ls, NREAL + 256 * s, G.Ls / 64, lds, 16 + qb * 256, qn);
#else
    attn_body2(Q + (size_t)qrow * LDQ + h * 192, Kb + h * 192, Vb + h * 128, O + (size_t)qrow * LDO + h * 128, s * G.Ls, NREAL + 256 * s, G.Ls / 64, lds, ldsL, 16 + qb * 256, qn);
#endif
  }
}

constexpr int LGP = 129;
__device__ __forceinline__ float logsigmoidf_(float x) { return fminf(x, 0.f) - log1pf(__expf(-fabsf(x))); }
LPHASE void phase_gla_prep(char* ws_, const float* x_, float* out_, const float* meta_, int nseq_, char* lds) {
  const int tid0 = TIDX();
  char* wsp = opaque(ws_);
  const bf16_t* b2 = (const bf16_t*)(wsp + O_B2); const bf16_t* b4 = (const bf16_t*)(wsp + O_B4);
  char* gp = wsp + O_GP;
  float* lgF = (float*)lds; float* lgB = lgF + 64 * LGP;
  char* R2 = lds + 2 * 64 * LGP * 4;
  bf16_t* qhF = (bf16_t*)R2; bf16_t* khF = qhF + 64 * 128; bf16_t* qhB = khF + 64 * 128; bf16_t* khB = qhB + 64 * 128;
  float* af = (float*)R2;
  bf16_t* vt = (bf16_t*)(R2 + 8192);
  float* tot = (float*)(R2 + 65536);
  const float* smg = (const float*)(wsp + O_SMALL);
  const int nmeta = 4 * nseq_, bid = BIDX();
  for (int kk = (bid < nmeta ? -1 : 0); ; ++kk) {
    const int it = kk < 0 ? 1024 + bid : bid + kk * (int)gridDim.x;
    if (kk >= 0 && it >= 1024) break;
    int tid_ = tid0; asm volatile("" : "+v"(tid_));
    const int tid = tid_, wid = tid >> 6, lane = tid & 63, d = tid & 127, ig = tid >> 7;
    const int ch = it >> 2, hd = it & 3;
    const bool ismeta = ch >= 256;
    const int row0 = ismeta ? NREAL + 256 * (ch - 256) : ch * 64;
    unsigned qk[16];
    { const unsigned voff = (unsigned)(ig * 16 * 2048 + d) * 2u;
      const char* ub = (const char*)(b2 + (size_t)row0 * 2048 + hd * 128);
#pragma unroll
      for (int ii = 0; ii < 16; ++ii) { const char* ubi = ub + ii * 4096;
        qk[ii] = (unsigned)*(const bf16_t*)(ubi + voff) | ((unsigned)*(const bf16_t*)(ubi + 1024 + voff) << 16); } }
    {
#pragma unroll
      for (int q = 0; q < 4; ++q) { const int c = tid + q * NTHR, i = c >> 5, c8 = (c & 31) * 8;
        *(u32x4*)(vt + i * 264 + c8) = *(const u32x4*)(b2 + (size_t)(row0 + i) * 2048 + 1024 + hd * 256 + c8); }
      for (int e = tid; e < 64 * 32; e += NTHR) { const int i = e >> 5, c = e & 31; af[e] = bf2f(b4[(size_t)(row0 + i) * 256 + 64 + c]); }
    }
    __syncthreads();
    { bf16_t* dst = (bf16_t*)(gp + GP_VT) + ((size_t)ch * 4 + hd) * 256 * 64;
#pragma unroll
      for (int q = 0; q < 4; ++q) { const int i8 = (tid & 7) * 8, c = (tid >> 3) + 64 * q; bf16x8 w;
#pragma unroll
        for (int e = 0; e < 8; ++e) w[e] = (short)vt[(i8 + e) * 264 + c];
        *(bf16x8*)(dst + c * 64 + i8) = w; } }
    { float wf[16], wb[16];
#pragma unroll
      for (int k = 0; k < 16; ++k) { wf[k] = smg[S_WAF + k * 512 + hd * 128 + d]; wb[k] = smg[S_WAB + k * 512 + hd * 128 + d]; }
      const float bfv = smg[S_BAF + hd * 128 + d], bbv = smg[S_BAB + hd * 128 + d];
      float tfl = 0.f, tbl = 0.f;
#pragma unroll 2
      for (int ii = 0; ii < 16; ++ii) { const int i = ig * 16 + ii; float sf = bfv, sb = bbv; const float* a = af + i * 32;
#pragma unroll
        for (int k = 0; k < 16; ++k) { sf += a[k] * wf[k]; sb += a[16 + k] * wb[k]; }
        float lf = (fminf(sf, 0.f) - __logf(1.f + __expf(-fabsf(sf)))) * (1.f / 16.f), lb = (fminf(sb, 0.f) - __logf(1.f + __expf(-fabsf(sb)))) * (1.f / 16.f);
        if (ismeta && i >= 16) { lf = 0.f; lb = 0.f; }
        lgF[i * LGP + d] = lf; lgB[i * LGP + d] = lb; tfl += lf; tbl += lb; }
      tot[ig * 128 + d] = tfl; tot[512 + ig * 128 + d] = tbl;
    }
    __syncthreads();
    { const float t0 = tot[d], t1 = tot[128 + d], t2 = tot[256 + d], t3 = tot[384 + d];
      const float u0 = tot[512 + d], u1 = tot[640 + d], u2 = tot[768 + d], u3 = tot[896 + d];
      const float blF = (t0 + t1) + (t2 + t3), brF = t0 + t1, blB = (u0 + u1) + (u2 + u3), brB = u2 + u3;
      const float offF = ig == 0 ? 0.f : ig == 1 ? t0 : ig == 2 ? t0 + t1 : (t0 + t1) + t2;
      const float offB = ig == 3 ? 0.f : ig == 2 ? u3 : ig == 1 ? u2 + u3 : (u1 + u2) + u3;
      const float myB = ig == 0 ? u0 : ig == 1 ? u1 : ig == 2 ? u2 : u3;
      if (ig == 0) { float* dc = (float*)(gp + GP_DC) + ((size_t)ch * 4 + hd) * 2 * 128; dc[d] = __expf(blF); dc[128 + d] = __expf(blB); }
      bf16_t* qtF = (bf16_t*)(gp + GP_QT) + (((size_t)ch * 4 + hd) * 2 + 0) * 64 * 128; bf16_t* qtB = qtF + 64 * 128;
      float runF = offF, runB = offB + myB;
#pragma unroll
      for (int ii = 0; ii < 16; ++ii) { const int i = ig * 16 + ii;
        const float q = bflo(qk[ii]) * 0.08838834764831845f, k = bfhi(qk[ii]);
        const float lf = lgF[i * LGP + d], lb = lgB[i * LGP + d];
        runF += lf; const float bcF = runF, bcB = runB; runB -= lb;
        qtF[i * 128 + d] = f2bf(q * __expf(bcF)); qtB[i * 128 + d] = f2bf(q * __expf(bcB));
        qhF[i * 128 + d] = f2bf(q * __expf(bcF - brF)); khF[i * 128 + d] = f2bf(k * __expf(brF - bcF));
        qhB[i * 128 + d] = f2bf(q * __expf(bcB - brB)); khB[i * 128 + d] = f2bf(k * __expf(brB - bcB));
        lgF[i * LGP + d] = k * __expf(blF - bcF); lgB[i * LGP + d] = k * __expf(blB - bcB);
        if ((ii & 1) == 1) asm volatile("" ::: "memory"); }
    }
    __syncthreads();
    { bf16_t* ktF = (bf16_t*)(gp + GP_KT) + (((size_t)ch * 4 + hd) * 2 + 0) * 128 * 64; bf16_t* ktB = ktF + 128 * 64;
#pragma unroll
      for (int q = 0; q < 2; ++q) { const int i8 = (tid & 7) * 8, dd = (tid >> 3) + 64 * q; float f[8];
#pragma unroll
        for (int e = 0; e < 8; ++e) f[e] = lgF[(i8 + e) * LGP + dd];
        *(u32x4*)(ktF + dd * 64 + i8) = pack8(f);
#pragma unroll
        for (int e = 0; e < 8; ++e) f[e] = lgB[(i8 + e) * LGP + dd];
        *(u32x4*)(ktB + dd * 64 + i8) = pack8(f); }
      const int dir = wid >> 2, qi = (wid >> 1) & 1, qj = wid & 1, r32 = lane & 31, hi = lane >> 5;
      const bf16_t* qh = dir ? qhB : qhF; const bf16_t* kh = dir ? khB : khF;
      f32x16 acc = {};
#pragma unroll
      for (int ks = 0; ks < 8; ++ks) {
        const bf16x8 a = *(const bf16x8*)(qh + (32 * qi + r32) * 128 + ks * 16 + hi * 8);
        const bf16x8 b = *(const bf16x8*)(kh + (32 * qj + r32) * 128 + ks * 16 + hi * 8);
        acc = __builtin_amdgcn_mfma_f32_32x32x16_bf16(a, b, acc, 0, 0, 0); }
      bf16_t* am = (bf16_t*)(gp + GP_AM) + (((size_t)ch * 4 + hd) * 2 + dir) * 64 * 64;
#pragma unroll
      for (int r = 0; r < 16; ++r) { const int i = 32 * qi + crow(r, hi), j = 32 * qj + r32;
        const bool keep = dir ? (i <= j) : (i >= j);
        am[i * 64 + j] = f2bf(keep ? acc[r] : 0.f); }
    }
    __syncthreads();
  }
}

constexpr int GS_QT = 0, GS_KT = 16384, GS_AM = 32768, GS_DC = 40960, GS_STAGE = 41472;
#define GS_WAIT(n) asm volatile("s_waitcnt vmcnt(" #n ")" ::: "memory")
template <bool FINAL>
LPHASE void phase_gla_scan(char* ws_, int nseq_, char* ldsg, LAS unsigned char* lds) {
  const int tid = TIDX(), wid = __builtin_amdgcn_readfirstlane(tid >> 6), lane = tid & 63, fr = lane & 15, fq = lane >> 4;
  char* wsp = opaque(ws_);
  char* gp = wsp + O_GP;
  const int Ls = nseq_ == 2 ? 8192 : 16384;
  const int CS = Ls / 64, nls = CS / 16;
  unsigned oq[2], ok[2], oa;
#pragma unroll
  for (int j = 0; j < 2; ++j) { const int pq = 128 * wid + 64 * j + lane, rq = pq >> 4, cq = (pq & 15) ^ (rq & 15); oq[j] = (unsigned)(rq * 256 + cq * 16);
    const int pk = 128 * wid + 64 * j + lane, rk = pk >> 3, ck = (pk & 7) ^ (rk & 7); ok[j] = (unsigned)(rk * 128 + ck * 16); }
  { const int pa = 64 * wid + lane, ra = pa >> 3, ca = (pa & 7) ^ (ra & 7); oa = (unsigned)(ra * 128 + ca * 16); }
  for (int it = BIDX(); it < 256; it += gridDim.x) {
    const int half = it & 1, dir = (it >> 1) & 1, hd = (it >> 2) & 3, sg = it >> 4;
    const int s = sg / nls, ls = sg % nls;
    const int colb = half * 128 + wid * 16;
    float* Ub = (float*)(gp + GP_U); float* Db = (float*)(gp + GP_D);
    const bool has_meta = (dir == 0 && ls == 0);
    const int nsteps = 16 + (has_meta ? 1 : 0);
    auto chunk_of = [&](int st) -> int {
      if (dir == 0) { if (has_meta) return st == 0 ? 256 + s : s * CS + (st - 1); return s * CS + ls * 16 + st; }
      return s * CS + ls * 16 + (15 - st); };
    bf16x8 v0a, v0b, v1a, v1b, v2a, v2b;
#define GS_ISSUE(st_, sgi_, VA, VB) do { const int _st = (st_) < nsteps ? (st_) : nsteps - 1; const int _ch = chunk_of(_st); const size_t _cb = ((size_t)_ch * 4 + hd) * 2 + dir; \
      const unsigned _lb = (unsigned)(sgi_) * GS_STAGE; \
      const char* _kt = gp + GP_KT + _cb * 16384; \
      __builtin_amdgcn_global_load_lds((const unsigned*)(_kt + ok[0]), (LAS unsigned*)(lds + _lb + GS_KT + (128 * wid) * 16), 16, 0, 0); \
      __builtin_amdgcn_global_load_lds((const unsigned*)(_kt + ok[1]), (LAS unsigned*)(lds + _lb + GS_KT + (128 * wid + 64) * 16), 16, 0, 0); \
      if (FINAL) { const char* _qt = gp + GP_QT + _cb * 16384; const char* _am = gp + GP_AM + _cb * 8192; \
        __builtin_amdgcn_global_load_lds((const unsigned*)(_qt + oq[0]), (LAS unsigned*)(lds + _lb + GS_QT + (128 * wid) * 16), 16, 0, 0); \
        __builtin_amdgcn_global_load_lds((const unsigned*)(_qt + oq[1]), (LAS unsigned*)(lds + _lb + GS_QT + (128 * wid + 64) * 16), 16, 0, 0); \
        __builtin_amdgcn_global_load_lds((const unsigned*)(_am + oa), (LAS unsigned*)(lds + _lb + GS_AM + (64 * wid) * 16), 16, 0, 0); } \
      if (lane < 4) __builtin_amdgcn_global_load_lds((const unsigned*)(gp + GP_DC + _cb * 512 + (4 * wid + lane) * 16), (LAS unsigned*)(lds + _lb + GS_DC + (4 * wid) * 16), 16, 0, 0); \
      const bf16_t* _vt = (const bf16_t*)(gp + GP_VT) + ((size_t)_ch * 4 + hd) * 256 * 64 + (size_t)(colb + fr) * 64; \
      VA = *(const bf16x8*)(_vt + fq * 8); VB = *(const bf16x8*)(_vt + 32 + fq * 8); } while (0)
    GS_ISSUE(0, 0, v0a, v0b);
    GS_ISSUE(1, 1, v1a, v1b);
    f32x4 S[8];
#pragma unroll
    for (int t = 0; t < 8; ++t) S[t] = (f32x4){0.f, 0.f, 0.f, 0.f};
    f32x4 Dc[8];
#pragma unroll
    for (int t = 0; t < 8; ++t) Dc[t] = (f32x4){1.f, 1.f, 1.f, 1.f};
    if (FINAL) {
      const int np = dir ? (nls - 1 - ls) : ls;
      f32x4 W[8];
#pragma unroll
      for (int t = 0; t < 8; ++t) W[t] = (f32x4){1.f, 1.f, 1.f, 1.f};
#pragma unroll 2
      for (int q = 0; q < np; ++q) { const int ps = dir ? (ls + 1 + q) : (ls - 1 - q); const int psg = s * nls + ps;
        const f32x4* U = (const f32x4*)(Ub + (((size_t)psg * 4 + hd) * 2 + dir) * 128 * 256) + ((size_t)(colb >> 4) * 8) * 64 + lane; const float* D = Db + (((size_t)psg * 4 + hd) * 2 + dir) * 128;
#pragma unroll
        for (int t = 0; t < 8; ++t) { const f32x4 dv = *(const f32x4*)(D + 16 * t + 4 * fq); const f32x4 uv = U[t * 64];
          S[t] += W[t] * uv; W[t] *= dv; } }
    }
    for (int st = 0; st < nsteps; ++st) {
      const bool metastep = has_meta && st == 0;
      const bool prev_stores = FINAL && st > 0 && !(has_meta && st == 1);
      if (FINAL) { if (prev_stores) GS_WAIT(24); else GS_WAIT(8); } else GS_WAIT(5);
      asm volatile("s_waitcnt lgkmcnt(0)" ::: "memory"); __builtin_amdgcn_s_barrier(); asm volatile("" ::: "memory");
      const int sgi2 = (st + 2) % 3;
      GS_ISSUE(st + 2, sgi2, v2a, v2b);
      const char* L = ldsg + (st % 3) * GS_STAGE;
      if (FINAL && !metastep) {
        const int ch = chunk_of(st);
        bf16x8 sB[4];
#pragma unroll
        for (int ks = 0; ks < 4; ++ks) { u32x4 w; w.x = cvtpk(S[2 * ks][0], S[2 * ks][1]); w.y = cvtpk(S[2 * ks][2], S[2 * ks][3]);
          w.z = cvtpk(S[2 * ks + 1][0], S[2 * ks + 1][1]); w.w = cvtpk(S[2 * ks + 1][2], S[2 * ks + 1][3]); sB[ks] = *reinterpret_cast<bf16x8*>(&w); }
        bf16_t* od = (bf16_t*)(wsp + O_OFB) + (size_t)dir * NREAL * 1024 + (size_t)(ch * 64) * 1024 + hd * 256 + colb + fr;
#pragma unroll
        for (int mt = 0; mt < 4; ++mt) {
          f32x4 o = (f32x4){0.f, 0.f, 0.f, 0.f};
          const char* ar = L + GS_AM + (16 * mt + fr) * 128;
          o = __builtin_amdgcn_mfma_f32_16x16x32_bf16(*(const bf16x8*)(ar + (((fq) ^ (fr & 7)) << 4)), v0a, o, 0, 0, 0);
          o = __builtin_amdgcn_mfma_f32_16x16x32_bf16(*(const bf16x8*)(ar + (((4 + fq) ^ (fr & 7)) << 4)), v0b, o, 0, 0, 0);
          const char* qrw = L + GS_QT + (16 * mt + fr) * 256 + (fq & 1) * 8;
#pragma unroll
          for (int ks = 0; ks < 4; ++ks) { const s16x4 lo = *(const s16x4*)(qrw + (((4 * ks + (fq >> 1)) ^ fr) << 4)), hi4 = *(const s16x4*)(qrw + (((4 * ks + 2 + (fq >> 1)) ^ fr) << 4));
            const bf16x8 a = (bf16x8){lo[0], lo[1], lo[2], lo[3], hi4[0], hi4[1], hi4[2], hi4[3]};
            o = __builtin_amdgcn_mfma_f32_16x16x32_bf16(a, sB[ks], o, 0, 0, 0); }
#pragma unroll
          for (int j = 0; j < 4; ++j) od[(size_t)(16 * mt + 4 * fq + j) * 1024] = f2bf(o[j]);
        }
      }
#pragma unroll
      for (int t = 0; t < 8; ++t) { const f32x4 dv = *(const f32x4*)(L + GS_DC + (16 * t + 4 * fq) * 4);
        S[t] *= dv; if (!FINAL) Dc[t] *= dv;
        const char* kr = L + GS_KT + (16 * t + fr) * 128;
        S[t] = __builtin_amdgcn_mfma_f32_16x16x32_bf16(*(const bf16x8*)(kr + (((fq) ^ (fr & 7)) << 4)), v0a, S[t], 0, 0, 0);
        S[t] = __builtin_amdgcn_mfma_f32_16x16x32_bf16(*(const bf16x8*)(kr + (((4 + fq) ^ (fr & 7)) << 4)), v0b, S[t], 0, 0, 0); }
      v0a = v1a; v0b = v1b; v1a = v2a; v1b = v2b;
    }
    GS_WAIT(0); __syncthreads();
    if (!FINAL) {
      float* U = Ub + (((size_t)sg * 4 + hd) * 2 + dir) * 128 * 256; float* D = Db + (((size_t)sg * 4 + hd) * 2 + dir) * 128;
#pragma unroll
      for (int t = 0; t < 8; ++t) {
        ((f32x4*)U)[((size_t)(colb >> 4) * 8 + t) * 64 + lane] = S[t];
        if (half == 0 && wid == 0 && fr == 0) *(f32x4*)(D + 16 * t + 4 * fq) = Dc[t]; }
    }
#undef GS_ISSUE
  }
}

#ifndef NO_GEMM
#define GEMMCALL(l,g,e) gemm_phase(l,g,e)
#else
#define GEMMCALL(l,g,e) (void)0
#endif
#define LA p.ws, G.x, G.out, p.meta, G.nseq

#define XB_TMO      128
#define XB_XCNT(j)  (256  + 64 * (j))
#define XB_XSUB(j)  (1280 + 64 * (j))
#define XB_XGEN(j)  (2304 + 64 * (j))
#define XB_TOP      3328
#define XB_TOPGEN   3392
#define XCD_BAR_WORDS 3456
#define XB_SPIN_CAP (1u << 22)
__device__ __forceinline__ unsigned xb_ld(unsigned* p)              { return __hip_atomic_load(p, __ATOMIC_RELAXED, __HIP_MEMORY_SCOPE_AGENT); }
__device__ __forceinline__ unsigned xb_add(unsigned* p, unsigned v) { return __hip_atomic_fetch_add(p, v, __ATOMIC_RELAXED, __HIP_MEMORY_SCOPE_AGENT); }
__device__ __forceinline__ unsigned xb_xcc_id() { return (unsigned)__builtin_amdgcn_s_getreg((3 << 11) | 20) & 0xFu; }
#define XB_SPIN(cond, bar) do { unsigned _sp = 0; while (cond) { __builtin_amdgcn_s_sleep(1); \
    if ((++_sp & 255u) == 0u) { if (xb_ld(&(bar)[XB_TMO])) break; if (_sp > XB_SPIN_CAP) { atomicAdd(&(bar)[XB_TMO], 1u); break; } } } } while (0)
struct XcdBarrier { unsigned* bar; unsigned x; volatile LAS unsigned* st; };
__device__ __forceinline__ XcdBarrier xcd_barrier_post(unsigned* bar, volatile LAS unsigned* st) {
  XcdBarrier b; b.bar = bar; b.x = xb_xcc_id(); b.st = st;
  if (threadIdx.x == 0) (void)xb_add(&bar[XB_XCNT(b.x)], 1u);
  return b;
}
__device__ __forceinline__ void xcd_barrier_complete(unsigned* bar, unsigned x, unsigned& nloc, unsigned& nx) {
  const unsigned G = gridDim.x * gridDim.y * gridDim.z;
  unsigned sum, cnt, mine, sp = 0u;
  for (;;) {
    sum = 0u; cnt = 0u; mine = 0u;
#pragma unroll
    for (unsigned j = 0; j < 16; ++j) { const unsigned c = xb_ld(&bar[XB_XCNT(j)]); sum += c; cnt += (c > 0u) ? 1u : 0u; mine = (j == x) ? c : mine; }
    if (sum == G) break;
    __builtin_amdgcn_s_sleep(1);
    if ((++sp & 255u) == 0u) { if (xb_ld(&bar[XB_TMO])) break; if (sp > XB_SPIN_CAP) { atomicAdd(&bar[XB_TMO], 1u); break; } }
  }
  nloc = mine > 0u ? mine : 1u; nx = cnt > 0u ? cnt : 1u;
}
__device__ __forceinline__ void xcd_barrier(const XcdBarrier& b) {
  asm volatile("s_waitcnt vmcnt(0)" ::: "memory");
  __syncthreads();
  if (threadIdx.x == 0) {
    unsigned* bar = b.bar;
    __builtin_amdgcn_s_waitcnt(0);
    unsigned nloc = b.st[0], nx = b.st[1];
    if (nloc == 0u) { xcd_barrier_complete(bar, b.x, nloc, nx); b.st[0] = nloc; b.st[1] = nx; }
    const unsigned old = xb_add(&bar[XB_XSUB(b.x)], 1u);
    const unsigned gen = old / nloc;
    if (old + 1u == (gen + 1u) * nloc) {
      __builtin_amdgcn_fence(__ATOMIC_RELEASE, "agent");
      asm volatile("s_waitcnt vmcnt(0)" ::: "memory");
      const unsigned og = xb_add(&bar[XB_TOP], 1u);
      const unsigned tg = og / nx;
      if (og + 1u == (tg + 1u) * nx) xb_add(&bar[XB_TOPGEN], 1u);
      else XB_SPIN(xb_ld(&bar[XB_TOPGEN]) == tg, bar);
      __builtin_amdgcn_fence(__ATOMIC_ACQUIRE, "agent");
      xb_add(&bar[XB_XGEN(b.x)], 1u);
      asm volatile("s_waitcnt vmcnt(0)" ::: "memory");
    } else {
      XB_SPIN(xb_ld(&bar[XB_XGEN(b.x)]) == gen, bar);
      __builtin_amdgcn_fence(__ATOMIC_ACQUIRE, "agent");
      asm volatile("s_waitcnt vmcnt(0)" ::: "memory");
    }
  }
  __syncthreads();
}
struct EpiGen { int kind, kind2; bf16_t *b0, *b1, *b2, *b3; float* f0; const float* cf0;
  __device__ __forceinline__ void st2(int w, int r, int c, f32x4 v0, f32x4 v1) const {
    switch (w ? kind2 : kind) {
      case 0: { EpiInproj E{b0, b1, b2, b3}; E.st(r, c, v0, v1); } break;
      case 1: { EpiBf16 E{b0, 1536}; E.st(r, c, v0, v1); } break;
      case 2: { EpiKV E{b0, b1}; E.st(r, c, v0, v1); } break;
      case 3: { EpiGateA E{b0, b2}; E.st(r, c, v0, v1); } break;
      case 4: { EpiGateB E{b0, b2, b1}; E.st(r, c, v0, v1); } break;
      case 5: { EpiX1 E{cf0, f0}; E.st(r, c, v0, v1); } break;
      case 6: { EpiFfnUp E{b0}; E.st(r, c, v0, v1); } break;
      default: { EpiFfnDown E{f0}; E.st(r, c, v0, v1); } break;
    }
  } };

constexpr int NSTEP_G = 17;
__global__ void __launch_bounds__(NTHR, 2) mega(Params p) {
  extern __shared__ __attribute__((aligned(16))) unsigned char lds_raw[];
  cg::grid_group grid = cg::this_grid();
  LAS unsigned char* lds = (LAS unsigned char*)lds_raw;
  char* ldsg = (char*)lds_raw;
  if (threadIdx.x < 4) ((LAS unsigned*)(lds + LDS_BYTES - 16))[threadIdx.x] = 0u;
  __syncthreads();
  const XcdBarrier xb = xcd_barrier_post((unsigned*)(p.ws + O_BAR), (volatile LAS unsigned*)(lds + LDS_BYTES - 16));
  phase_weights(p);
  grid.sync();
#ifdef PROBE_AT
  constexpr int NSTP = NSTEP_G + 1;
#else
  constexpr int NSTP = NSTEP_G;
#endif
#pragma unroll 1
  for (int step = 0; step < 3 * NSTP; ++step) {
    const int g = step / NSTP; int ph = step % NSTP;
#ifdef PROBE_AT
    ph -= (ph > PROBE_AT) ? 1 : 0;
#endif
    char* ws = opaque(p.ws);
    const Grp G = make_grp(p, g);
    bool is_gemm = false, sync_after = true;
    Gemm gm{nullptr, nullptr, 1024, 1024, NREAL, 1024, 1024, nullptr, nullptr};
    EpiGen E{0, 0, nullptr, nullptr, nullptr, nullptr, nullptr, nullptr};
    switch (ph) {
      case 0: rows_h(LA); break;
      case 1: is_gemm = true; gm = Gemm{(const bf16_t*)(ws + O_H), (const bf16_t*)(ws + O_WIN), 1024, 1024, G.RG, NIN, 1024, nullptr, nullptr};
              E.kind = 0; E.b0 = (bf16_t*)(ws + O_B1); E.b1 = (bf16_t*)(ws + O_B2); E.b2 = (bf16_t*)(ws + O_G3); E.b3 = (bf16_t*)(ws + O_B4); break;
      case 2: rows_cnorm(LA); sync_after = false; break;
#ifndef NO_PREP
      case 3: phase_gla_prep(p.ws, G.x, G.out, p.meta, G.nseq, ldsg); break;
#endif
      case 4: is_gemm = true; sync_after = false; gm = Gemm{(const bf16_t*)(ws + O_B1), (const bf16_t*)(ws + O_WUQ), 1024, 768, G.RG, 1536, 768, nullptr, nullptr};
              E.kind = 1; E.b0 = (bf16_t*)G.out; break;
      case 5: is_gemm = true; sync_after = false; gm = Gemm{(const bf16_t*)(ws + O_B1) + 768, (const bf16_t*)(ws + O_WUKV), 1024, 256, G.RG, 2048, 256, nullptr, nullptr};
              E.kind = 2; E.b0 = (bf16_t*)(ws + O_KNR); E.b1 = (bf16_t*)(ws + O_V); break;
#ifndef NO_SCAN
      case 6: phase_gla_scan<false>(p.ws, G.nseq, ldsg, lds); break;
#endif
      case 7: rows_qk(LA); sync_after = false; break;
#ifndef NO_SCAN2
      case 8: phase_gla_scan<true>(p.ws, G.nseq, ldsg, lds); break;
#endif
      case 9: rows_ogla(LA); sync_after = false; break;
      case 10: phase_attn(p, G, ldsg, lds); break;
      case 11: is_gemm = true; gm = Gemm{(const bf16_t*)(ws + O_OMLA), (const bf16_t*)(ws + O_WOM), 1024, 1024, NREAL, 1024, 1024, (const bf16_t*)(ws + O_OGLA), (const bf16_t*)(ws + O_WOG)};
              E.kind = 3; E.kind2 = 4; E.b0 = (bf16_t*)(ws + O_G3); E.b2 = (bf16_t*)(ws + O_TMP); E.b1 = (bf16_t*)(ws + O_MIX); break;
      case 12: sync_after = false; break;
      case 13: is_gemm = true; gm = Gemm{(const bf16_t*)(ws + O_MIX), (const bf16_t*)(ws + O_WOUT), 1024, 1024, NREAL, 1024, 1024, nullptr, nullptr};
              E.kind = 5; E.cf0 = G.x; E.f0 = G.out; break;
      case 14: rows_h2(LA); break;
      case 15: is_gemm = true; gm = Gemm{(const bf16_t*)(ws + O_H2), (const bf16_t*)(ws + O_WGU), 1024, 1024, NREAL, 5632, 1024, nullptr, nullptr};
              E.kind = 6; E.b0 = (bf16_t*)(ws + O_ACT); break;
      default: is_gemm = true; gm = Gemm{(const bf16_t*)(ws + O_ACT), (const bf16_t*)(ws + O_WD), DFF, DFF, NREAL, 1024, DFF, nullptr, nullptr};
              E.kind = 7; E.f0 = G.out; break;
    }
    if (is_gemm) gemm_phase(lds, gm, E);
    if (sync_after) xcd_barrier(xb);
  }
}

extern "C" void kernel_launch(void* const* d_in, const int* in_sizes, int n_in, void* d_out, int out_size, void* d_ws, size_t ws_size, hipStream_t stream) {
  static int grid_blocks = 0;
  if (grid_blocks == 0) {
    if (n_in != 23 || ws_size < WS_END) { fprintf(stderr, "kernel_launch: unexpected inputs (n_in %d, ws %zu, need %zu)\n", n_in, ws_size, (size_t)WS_END); grid_blocks = -1; return; }
    int dev = 0, cus = 0, per_cu = 0;
    (void)hipGetDevice(&dev); (void)hipDeviceGetAttribute(&cus, hipDeviceAttributeMultiprocessorCount, dev);
    if (hipFuncSetAttribute((const void*)mega, hipFuncAttributeMaxDynamicSharedMemorySize, LDS_BYTES) != hipSuccess) { fprintf(stderr, "kernel_launch: hipFuncSetAttribute failed\n"); grid_blocks = -1; return; }
    if (hipOccupancyMaxActiveBlocksPerMultiprocessor(&per_cu, (const void*)mega, NTHR, LDS_BYTES) != hipSuccess || per_cu < 1) { fprintf(stderr, "kernel_launch: occupancy query gives %d\n", per_cu); per_cu = 1; }
    (void)hipGetLastError();
    grid_blocks = cus * per_cu;
    if (grid_blocks > 256) grid_blocks = 256;
  }
  if (grid_blocks < 0) return;
  Params p{};
  const float** pp = (const float**)&p;
  for (int i = 0; i < 23; ++i) pp[i] = (const float*)d_in[i];
  p.out = (float*)d_out; p.ws = (char*)d_ws;
  (void)hipMemsetAsync((char*)d_ws + O_BAR, 0, 3456 * 4, stream);
  void* args[] = {&p};
  hipError_t e = hipLaunchCooperativeKernel((const void*)mega, dim3(grid_blocks), dim3(NTHR), args, LDS_BYTES, stream);
  if (e != hipSuccess) fprintf(stderr, "cooperative launch failed: %s (grid %d)\n", hipGetErrorString(e), grid_blocks);
}
```
